# Optimizing an MI355X kernel written in HIP

```python
import math
import jax, jax.numpy as jnp
from jax import lax
import numpy as np

D_MODEL = 1024
BATCH = 8
SEQ = 4096
DEPTH = 1

D_SSM = D_MODEL
SSM_GROUP = 16
N_GROUPS = D_SSM // SSM_GROUP
STATE = 64
N_DIR = 2
DT_MIN = 1e-3
DT_MAX = 1e-1
D_CONV = D_MODEL
CONV_W = 3
EPS = 1e-6
SPLIT_SIZES = (D_SSM, D_SSM, D_CONV, D_CONV, D_CONV, D_CONV, D_MODEL, D_MODEL)
D_IN_PROJ = sum(SPLIT_SIZES)

kernel_name = "hybrid_s5_shortconv_gated_block"


def rmsnorm(x, g):
    xf = x.astype(jnp.float32)
    xf = xf * lax.rsqrt(jnp.mean(xf * xf, axis=-1, keepdims=True) + EPS)
    return (xf * g.astype(jnp.float32)).astype(x.dtype)


def cmul(ar, ai, br, bi):
    return ar * br - ai * bi, ar * bi + ai * br


def s5_scan(u, lam_re, lam_im, log_dt, b_re, b_im, c_re, c_im, reverse):
    lam_re = lam_re.astype(jnp.float32)
    lam_im = lam_im.astype(jnp.float32)
    dt = jnp.exp(log_dt.astype(jnp.float32))[:, None]
    mag = jnp.exp(lam_re * dt)
    ab_re, ab_im = mag * jnp.cos(lam_im * dt), mag * jnp.sin(lam_im * dt)
    den = lam_re * lam_re + lam_im * lam_im
    nr, ni = ab_re - 1.0, ab_im
    coef_re = (nr * lam_re + ni * lam_im) / den
    coef_im = (ni * lam_re - nr * lam_im) / den
    bb_re, bb_im = cmul(coef_re[..., None], coef_im[..., None],
                        b_re.astype(jnp.float32), b_im.astype(jnp.float32))
    bu_re = jnp.einsum('blgh,gph->blgp', u, bb_re)
    bu_im = jnp.einsum('blgh,gph->blgp', u, bb_im)
    a_re = jnp.broadcast_to(ab_re, bu_re.shape)
    a_im = jnp.broadcast_to(ab_im, bu_re.shape)

    def combine(e1, e2):
        a1r, a1i, b1r, b1i = e1
        a2r, a2i, b2r, b2i = e2
        ar, ai = cmul(a2r, a2i, a1r, a1i)
        tr, ti = cmul(a2r, a2i, b1r, b1i)
        return ar, ai, tr + b2r, ti + b2i

    _, _, s_re, s_im = lax.associative_scan(combine, (a_re, a_im, bu_re, bu_im),
                                            axis=1, reverse=reverse)
    return (jnp.einsum('blgp,ghp->blgh', s_re, c_re.astype(jnp.float32))
            - jnp.einsum('blgp,ghp->blgh', s_im, c_im.astype(jnp.float32)))


def setup_inputs(seed: int = 0) -> dict:
    key = jax.random.key(seed)
    ks = jax.random.split(key, 20)
    f32 = jnp.float32
    x = jax.random.normal(ks[0], (BATCH, SEQ, D_MODEL), f32)
    norm_g = 1.0 + 0.02 * jax.random.normal(ks[1], (DEPTH, D_MODEL), f32)
    w_in = jax.random.normal(ks[2], (DEPTH, D_MODEL, D_IN_PROJ), f32) * D_MODEL ** -0.5
    n = jnp.arange(STATE, dtype=f32)
    lam_re = -0.5 + 0.01 * jax.random.normal(ks[3], (DEPTH, N_DIR, N_GROUPS, STATE), f32)
    lam_im = math.pi * n + 0.01 * jax.random.normal(ks[4], (DEPTH, N_DIR, N_GROUPS, STATE), f32)
    log_dt = jax.random.uniform(ks[5], (DEPTH, N_DIR, N_GROUPS), f32,
                                minval=math.log(DT_MIN), maxval=math.log(DT_MAX))
    b_scale = (2.0 * SSM_GROUP) ** -0.5
    c_scale = (2.0 * STATE) ** -0.5
    ssm_b_re = jax.random.normal(ks[6], (DEPTH, N_DIR, N_GROUPS, STATE, SSM_GROUP), f32) * b_scale
    ssm_b_im = jax.random.normal(ks[7], (DEPTH, N_DIR, N_GROUPS, STATE, SSM_GROUP), f32) * b_scale
    ssm_c_re = jax.random.normal(ks[8], (DEPTH, N_DIR, N_GROUPS, SSM_GROUP, STATE), f32) * c_scale
    ssm_c_im = jax.random.normal(ks[9], (DEPTH, N_DIR, N_GROUPS, SSM_GROUP, STATE), f32) * c_scale
    ssm_d = jax.random.normal(ks[10], (DEPTH, D_SSM), f32)
    w_glu = jax.random.normal(ks[11], (DEPTH, D_SSM, D_SSM), f32) * D_SSM ** -0.5
    conv_w = jax.random.normal(ks[12], (DEPTH, CONV_W, D_CONV), f32) * CONV_W ** -0.5
    conv_b = 0.01 * jax.random.normal(ks[13], (DEPTH, D_CONV), f32)
    w_branch_a = jax.random.normal(ks[14], (DEPTH, D_SSM, D_MODEL), f32) * D_SSM ** -0.5
    w_branch_b = jax.random.normal(ks[15], (DEPTH, D_CONV, D_MODEL), f32) * D_CONV ** -0.5
    w_out = jax.random.normal(ks[16], (DEPTH, D_MODEL, D_MODEL), f32) * D_MODEL ** -0.5
    final_g = 1.0 + 0.02 * jax.random.normal(ks[17], (D_MODEL,), f32)
    return {"x": x, "norm_g": norm_g, "w_in": w_in, "lam_re": lam_re, "lam_im": lam_im,
            "log_dt": log_dt, "ssm_b_re": ssm_b_re, "ssm_b_im": ssm_b_im,
            "ssm_c_re": ssm_c_re, "ssm_c_im": ssm_c_im, "ssm_d": ssm_d, "w_glu": w_glu,
            "conv_w": conv_w, "conv_b": conv_b, "w_branch_a": w_branch_a,
            "w_branch_b": w_branch_b, "w_out": w_out, "final_g": final_g}


def reference(x, norm_g, w_in, lam_re, lam_im, log_dt, ssm_b_re, ssm_b_im, ssm_c_re,
              ssm_c_im, ssm_d, w_glu, conv_w, conv_b, w_branch_a, w_branch_b, w_out,
              final_g):
    B, L, _ = x.shape
    split_idx = [int(i) for i in np.cumsum(np.array(SPLIT_SIZES))[:-1]]
    h = x
    for layer in range(DEPTH):
        xn = rmsnorm(h, norm_g[layer])
        proj = jnp.einsum('bld,de->ble', xn, w_in[layer])
        u, z_a, v, b_g, c_g, z_b, g_a, g_b = jnp.split(proj, split_idx, axis=-1)

        uf = u.astype(jnp.float32).reshape(B, L, N_GROUPS, SSM_GROUP)
        y = ssm_d[layer].astype(jnp.float32).reshape(N_GROUPS, SSM_GROUP) * uf
        for d in range(N_DIR):
            y = y + s5_scan(uf, lam_re[layer, d], lam_im[layer, d], log_dt[layer, d],
                            ssm_b_re[layer, d], ssm_b_im[layer, d],
                            ssm_c_re[layer, d], ssm_c_im[layer, d], reverse=(d == 1))
        y = jax.nn.gelu(y.reshape(B, L, D_SSM).astype(x.dtype))
        y = y * jax.nn.sigmoid(jnp.einsum('ble,ef->blf', y, w_glu[layer]))
        y_a = y * jax.nn.silu(z_a)

        cv = c_g * v
        pad = (CONV_W - 1) // 2
        cvp = jnp.pad(cv, ((0, 0), (pad, CONV_W - 1 - pad), (0, 0)))
        conv = conv_b[layer]
        for k in range(CONV_W):
            conv = conv + cvp[:, k:k + L] * conv_w[layer, k]
        y_b = b_g * conv * jax.nn.silu(z_b)

        o_a = jnp.einsum('ble,ed->bld', y_a, w_branch_a[layer])
        o_b = jnp.einsum('ble,ed->bld', y_b, w_branch_b[layer])
        merged = jax.nn.sigmoid(g_a) * o_a + jax.nn.sigmoid(g_b) * o_b
        h = h + jnp.einsum('bld,de->ble', merged, w_out[layer])
    return rmsnorm(h, final_g)
```

```cpp
#include <hip/hip_runtime.h>
#include <hip/hip_cooperative_groups.h>
#include <cstdio>
#include <cstdint>
namespace cg = cooperative_groups;
namespace pg8 {
#define PG8_LAS __attribute__((address_space(3)))
typedef unsigned short bf16_t;
typedef short bf16x8 __attribute__((ext_vector_type(8)));
typedef float f32x4 __attribute__((ext_vector_type(4)));
typedef unsigned u32x4 __attribute__((ext_vector_type(4)));
constexpr int BM = 256, BK = 64, HALF = 128, HTB = HALF * BK * 2  , STAGE_BYTES = 8 * HTB, NXCD = 8, WGM = 8;

__host__ __device__ __forceinline__ int lds_byte(int r, int c) { const int st = (r >> 4) * 2 + (c >> 5), rr = r & 15, cc = c & 31, ob = rr * 64 + cc * 2; return st * 1024 + (ob ^ (((ob >> 9) & 1) << 5)); }
__host__ __device__ __forceinline__ void stage_rc(int b, int& R, int& C) { const int st = b / 1024, sb = b % 1024, swz = sb ^ (((sb >> 9) & 1) << 5); R = (st >> 1) * 16 + swz / 64; C = (st & 1) * 32 + (swz % 64) / 2; }
__host__ __device__ __forceinline__ int perm32(int rho) { const int n = rho >> 4, i = rho & 15; return 8 * (i >> 2) + 4 * n + (i & 3); }

struct Unit { int pm, pn; };
struct Gemm { const bf16_t* A; const bf16_t* Bt; int lda, ldb, K; };

struct StaticOrder {
    int nM, nN, nwg, G, c;
    __host__ __device__ void init(int M, int N, int G_, int c_) { nM = M / BM; nN = N / BM; nwg = nM * nN; G = G_; c = c_; }
    __host__ __device__ bool next(int i, Unit& u) const {
        const long L = (long)i * G + c; if (L >= nwg) return false;
        int wgid = (int)L; { const int q = nwg / NXCD, r = nwg % NXCD, xcd = wgid % NXCD, off = wgid / NXCD; wgid = (xcd < r ? xcd * (q + 1) : r * (q + 1) + (xcd - r) * q) + off; }
        const int nig = WGM * nN, gid = wgid / nig, fm = gid * WGM, gsz = (nM - fm) < WGM ? (nM - fm) : WGM;
        u.pm = fm + ((wgid % nig) % gsz); u.pn = (wgid % nig) / gsz; return true;
    }
    __device__ __forceinline__ void a_ready(const Unit&) const {}
    __device__ __forceinline__ void done(const Unit&) const {}
};

template <class Epi, class Sched, bool ALIGN_EPI = false, bool SP2 = false>
__device__ __forceinline__ void gemm_phase(PG8_LAS unsigned char* lds, const Gemm g, const Sched& S, const Epi& E) {
    const int tid = threadIdx.x, wid = __builtin_amdgcn_readfirstlane(tid >> 6), lane = tid & 63, wr = wid >> 2, wc = wid & 3, fr = lane & 15, fq = lane >> 4;
    const int K = g.K, nt = K / BK;
    unsigned voffA[2], voffB[2];
#pragma unroll
    for (int i = 0; i < 2; ++i) { int R, C; stage_rc(tid * 16 + i * 8192, R, C); const int Rb = Epi::PERM ? ((R & ~31) + perm32(R & 31)) : R;
        voffA[i] = (unsigned)(R * g.lda + C) * 2u; voffB[i] = (unsigned)(Rb * g.ldb + C) * 2u; }
    const size_t kstep = (size_t)(BK * 2);
    const size_t hstepA = (size_t)HALF * g.lda * 2, hstepB = (size_t)HALF * g.ldb * 2;
    const size_t tstepA = 2 * hstepA, tstepB = 2 * hstepB;
    const unsigned ldsw = (unsigned)wid * 1024u;
    const int aoff = lds_byte(wr * 64 + fr, fq * 8), boff = lds_byte(wc * 32 + fr, fq * 8);
#define PG8_SA(b, h) (((b) * 2 + (h)) * HTB)
#define PG8_SB(b, h) ((4 + (b) * 2 + (h)) * HTB)
#define PG8_STAGE(bufoff, gbase, voff) do { _Pragma("unroll") for (int _i = 0; _i < 2; ++_i) \
        __builtin_amdgcn_global_load_lds((const unsigned*)((const char*)(gbase) + (voff)[_i]), (PG8_LAS unsigned*)(lds + (bufoff) + ldsw + _i * 8192), 16, 0, 0); } while (0)
#define PG8_LDA(dst, b, h) do { _Pragma("unroll") for (int m = 0; m < 4; ++m) _Pragma("unroll") for (int k = 0; k < 2; ++k) dst[m][k] = *(const PG8_LAS bf16x8*)(lds + PG8_SA(b, h) + aoff + m * 2048 + k * 1024); } while (0)
#define PG8_LDB(dst, b, h) do { _Pragma("unroll") for (int n = 0; n < 2; ++n) _Pragma("unroll") for (int k = 0; k < 2; ++k) dst[n][k] = *(const PG8_LAS bf16x8*)(lds + PG8_SB(b, h) + boff + n * 2048 + k * 1024); } while (0)
#define PG8_MMA(ai, bj, At, Bt) do { __builtin_amdgcn_s_setprio(1); _Pragma("unroll") for (int m = 0; m < 4; ++m) _Pragma("unroll") for (int n = 0; n < 2; ++n) _Pragma("unroll") for (int k = 0; k < 2; ++k) \
        acc[ai][bj][m][n] = __builtin_amdgcn_mfma_f32_16x16x32_bf16(Bt[n][k], At[m][k], acc[ai][bj][m][n], 0, 0, 0); __builtin_amdgcn_s_setprio(0); } while (0)
#define PG8_WAIT_V(n) asm volatile("s_waitcnt vmcnt(" #n ")" ::: "memory")
#define PG8_WAIT_L(n) asm volatile("s_waitcnt lgkmcnt(" #n ")" ::: "memory")
#define PG8_BAR __builtin_amdgcn_s_barrier()
#define PG8_SCHED __builtin_amdgcn_sched_barrier(0)
    Unit cur, nxt; int ui = 0;
    if (!S.next(0, cur)) return;
    f32x4 acc[2][2][4][2];
#pragma unroll
    for (int a = 0; a < 2; ++a)
#pragma unroll
        for (int b = 0; b < 2; ++b)
#pragma unroll
            for (int m = 0; m < 4; ++m)
#pragma unroll
                for (int n = 0; n < 2; ++n) acc[a][b][m][n] = (f32x4){0.f, 0.f, 0.f, 0.f};
    bf16x8 At[4][2], B0[2][2], B1[2][2];
    const char* cA = (const char*)g.A + (size_t)cur.pm * tstepA; const char* cB = (const char*)g.Bt + (size_t)cur.pn * tstepB;
    S.a_ready(cur);
    if constexpr (SP2) {
        PG8_STAGE(PG8_SB(0, 0), cB, voffB); PG8_STAGE(PG8_SB(0, 1), cB + hstepB, voffB); PG8_STAGE(PG8_SA(0, 0), cA, voffA); PG8_STAGE(PG8_SA(0, 1), cA + hstepA, voffA);
        if (wr == 1) PG8_BAR;
        PG8_WAIT_V(2); PG8_BAR;
        PG8_STAGE(PG8_SB(1, 0), cB + kstep, voffB); PG8_STAGE(PG8_SA(1, 0), cA + kstep, voffA); PG8_STAGE(PG8_SB(1, 1), cB + hstepB + kstep, voffB);
        PG8_WAIT_V(6); PG8_BAR;
    } else {
        PG8_STAGE(PG8_SB(0, 0), cB, voffB); PG8_STAGE(PG8_SA(0, 0), cA, voffA); PG8_STAGE(PG8_SB(0, 1), cB + hstepB, voffB); PG8_STAGE(PG8_SA(0, 1), cA + hstepA, voffA);
        if (wr == 1) PG8_BAR;
        PG8_WAIT_V(4); PG8_BAR;
        PG8_STAGE(PG8_SB(1, 0), cB + kstep, voffB); PG8_STAGE(PG8_SA(1, 0), cA + kstep, voffA); PG8_STAGE(PG8_SB(1, 1), cB + hstepB + kstep, voffB);
        PG8_WAIT_V(6); PG8_BAR;
    }
    for (;;) {
        const bool has_next = S.next(ui + 1, nxt);
        const char* nA = has_next ? (const char*)g.A + (size_t)nxt.pm * tstepA : cA; const char* nB = has_next ? (const char*)g.Bt + (size_t)nxt.pn * tstepB : cB;
        for (int t = 0; t < nt; t += 2) {
            const bool last = (t == nt - 2);
            const char* a1 = cA + (size_t)(t + 1) * kstep;
            const char* a2 = last ? nA : cA + (size_t)(t + 2) * kstep; const char* b2 = last ? nB : cB + (size_t)(t + 2) * kstep;
            const char* a3 = a2 + kstep; const char* b3 = b2 + kstep;
            if (last && has_next) S.a_ready(nxt);
            if constexpr (SP2) {
            PG8_LDB(B0, 0, 0); PG8_LDB(B1, 0, 1); PG8_SCHED; PG8_LDA(At, 0, 0); PG8_STAGE(PG8_SA(1, 1), a1 + hstepA, voffA);
            PG8_WAIT_V(8); PG8_WAIT_L(0); PG8_BAR; PG8_MMA(0, 0, At, B0); PG8_MMA(0, 1, At, B1); PG8_BAR; PG8_SCHED;
            PG8_LDA(At, 0, 1); PG8_STAGE(PG8_SB(0, 0), b2, voffB); PG8_STAGE(PG8_SB(0, 1), b2 + hstepB, voffB); PG8_STAGE(PG8_SA(0, 0), a2, voffA);
            PG8_WAIT_V(8); PG8_WAIT_L(0); PG8_BAR; PG8_MMA(1, 0, At, B0); PG8_MMA(1, 1, At, B1); PG8_BAR; PG8_SCHED;
            PG8_LDB(B0, 1, 0); PG8_LDB(B1, 1, 1); PG8_SCHED; PG8_LDA(At, 1, 0); PG8_STAGE(PG8_SA(0, 1), a2 + hstepA, voffA);
            PG8_WAIT_V(8); PG8_WAIT_L(0); PG8_BAR; PG8_MMA(0, 0, At, B0); PG8_MMA(0, 1, At, B1); PG8_BAR; PG8_SCHED;
            PG8_LDA(At, 1, 1); PG8_STAGE(PG8_SB(1, 0), b3, voffB); PG8_STAGE(PG8_SB(1, 1), b3 + hstepB, voffB); PG8_STAGE(PG8_SA(1, 0), a3, voffA);
            PG8_WAIT_V(8); PG8_WAIT_L(0); PG8_BAR; PG8_MMA(1, 0, At, B0); PG8_MMA(1, 1, At, B1); PG8_BAR; PG8_SCHED;
            } else {
            PG8_LDB(B0, 0, 0); PG8_SCHED; PG8_LDA(At, 0, 0); PG8_STAGE(PG8_SA(1, 1), a1 + hstepA, voffA);
            PG8_WAIT_L(8); PG8_BAR; PG8_WAIT_L(0); PG8_MMA(0, 0, At, B0); PG8_BAR; PG8_SCHED;
            PG8_LDB(B1, 0, 1); PG8_STAGE(PG8_SB(0, 0), b2, voffB);
            PG8_BAR; PG8_WAIT_L(0); PG8_MMA(0, 1, At, B1); PG8_BAR;
            PG8_LDA(At, 0, 1); PG8_STAGE(PG8_SA(0, 0), a2, voffA);
            PG8_BAR; PG8_WAIT_L(0); PG8_MMA(1, 0, At, B0); PG8_BAR; PG8_SCHED;
            PG8_STAGE(PG8_SB(0, 1), b2 + hstepB, voffB);
            PG8_WAIT_V(6); PG8_BAR; PG8_MMA(1, 1, At, B1); PG8_BAR;
            PG8_LDB(B0, 1, 0); PG8_SCHED; PG8_LDA(At, 1, 0); PG8_STAGE(PG8_SA(0, 1), a2 + hstepA, voffA);
            PG8_WAIT_L(8); PG8_BAR; PG8_WAIT_L(0); PG8_MMA(0, 0, At, B0); PG8_BAR; PG8_SCHED;
            PG8_LDB(B1, 1, 1); PG8_STAGE(PG8_SB(1, 0), b3, voffB);
            PG8_BAR; PG8_WAIT_L(0); PG8_MMA(0, 1, At, B1); PG8_BAR;
            PG8_LDA(At, 1, 1); PG8_STAGE(PG8_SA(1, 0), a3, voffA);
            PG8_BAR; PG8_WAIT_L(0); PG8_MMA(1, 0, At, B0); PG8_BAR; PG8_SCHED;
            PG8_STAGE(PG8_SB(1, 1), b3 + hstepB, voffB);
            PG8_WAIT_V(6); PG8_BAR; PG8_MMA(1, 1, At, B1); PG8_BAR;
            }
        }
        if constexpr (ALIGN_EPI) { if (wr == 0) PG8_BAR; }
        if constexpr (!Epi::AFTER_DRAIN) { E(acc, cur, wr, wc, fr, fq); S.done(cur); }
        if (!has_next) break;
#pragma unroll
        for (int a = 0; a < 2; ++a)
#pragma unroll
            for (int b = 0; b < 2; ++b)
#pragma unroll
                for (int m = 0; m < 4; ++m)
#pragma unroll
                    for (int n = 0; n < 2; ++n) acc[a][b][m][n] = (f32x4){0.f, 0.f, 0.f, 0.f};
        cur = nxt; cA = nA; cB = nB; ++ui;
        if constexpr (ALIGN_EPI) { if (wr == 1) PG8_BAR; }
    }
    PG8_WAIT_V(0);
    if constexpr (!ALIGN_EPI) { if (wr == 0) PG8_BAR; }
    PG8_BAR;
    if constexpr (Epi::AFTER_DRAIN) { E.fused(acc, cur, wr, wc, fr, fq, lds, wid, lane); S.done(cur); }
#undef PG8_SA
#undef PG8_SB
#undef PG8_STAGE
#undef PG8_LDA
#undef PG8_LDB
#undef PG8_MMA
#undef PG8_WAIT_V
#undef PG8_WAIT_L
#undef PG8_BAR
#undef PG8_SCHED
}
}
namespace pg8 {
typedef __bf16 bf16x2n __attribute__((ext_vector_type(2)));
typedef float f32x2n __attribute__((ext_vector_type(2)));
__device__ __forceinline__ unsigned cvt_pk_bf16(float lo, float hi) { const f32x2n v = {lo, hi}; const bf16x2n b = __builtin_convertvector(v, bf16x2n); return __builtin_bit_cast(unsigned, b); }
__device__ __forceinline__ float fsig(float x) { return __builtin_amdgcn_rcpf(1.0f + __builtin_amdgcn_exp2f(-1.44269504089f * x)); }
__device__ __forceinline__ float fsilu(float x) { return x * fsig(x); }
__device__ __forceinline__ float fgelu(float y) { return y * fsig(1.59576912161f * (y + 0.044715f * y * y * y)); }
__device__ __forceinline__ f32x4 vsig(f32x4 v) { return (f32x4){fsig(v[0]), fsig(v[1]), fsig(v[2]), fsig(v[3])}; }
__device__ __forceinline__ f32x4 vsilu(f32x4 v) { return (f32x4){fsilu(v[0]), fsilu(v[1]), fsilu(v[2]), fsilu(v[3])}; }
__device__ __forceinline__ f32x4 vgelu(f32x4 v) { return (f32x4){fgelu(v[0]), fgelu(v[1]), fgelu(v[2]), fgelu(v[3])}; }
__device__ __forceinline__ u32x4 pack8(f32x4 a, f32x4 b) { u32x4 w; w.x = cvt_pk_bf16(a[0], a[1]); w.y = cvt_pk_bf16(a[2], a[3]); w.z = cvt_pk_bf16(b[0], b[1]); w.w = cvt_pk_bf16(b[2], b[3]); return w; }
__device__ __forceinline__ void unpack8(u32x4 w, f32x4& a, f32x4& b) {
    a[0] = __uint_as_float(w.x << 16); a[1] = __uint_as_float(w.x & 0xffff0000u); a[2] = __uint_as_float(w.y << 16); a[3] = __uint_as_float(w.y & 0xffff0000u);
    b[0] = __uint_as_float(w.z << 16); b[1] = __uint_as_float(w.z & 0xffff0000u); b[2] = __uint_as_float(w.w << 16); b[3] = __uint_as_float(w.w & 0xffff0000u); }

struct EpiP1 {
    static constexpr bool PERM = true, AFTER_DRAIN = false;
    bf16_t *ACAT, *SZA, *CV, *BZ, *SGA, *SGB; int pn_off;
    __device__ __forceinline__ void operator()(const f32x4 (&acc)[2][2][4][2], const Unit& u, int wr, int wc, int fr, int fq) const {
        const int pn = u.pn + pn_off, row0 = u.pm * BM + wr * 64 + fr, cl = wc * 32 + 8 * fq;
        if (pn < 4) {
#pragma unroll
            for (int ai = 0; ai < 2; ++ai)
#pragma unroll
                for (int m = 0; m < 4; ++m) { const int r = row0 + ai * HALF + m * 16;
#pragma unroll
                    for (int bj = 0; bj < 2; ++bj) { const int col = pn * 256 + bj * HALF + cl, g = col >> 4, h0 = col & 15;
                        *(u32x4*)(ACAT + ((size_t)(g * 1024 + (r >> 5)) * 768 + (r & 31) * 16 + h0)) = pack8(acc[ai][bj][m][0], acc[ai][bj][m][1]); } }
        } else if (pn < 12) {
#pragma unroll
            for (int ai = 0; ai < 2; ++ai)
#pragma unroll
                for (int m = 0; m < 4; ++m) { bf16_t* rowp = CV + (size_t)(row0 + ai * HALF + m * 16) * 1024 + (pn - 4) * 128 + cl;
                    *(u32x4*)rowp = pack8(acc[ai][0][m][0] * acc[ai][1][m][0], acc[ai][0][m][1] * acc[ai][1][m][1]); }
        } else if (pn < 20) {
#pragma unroll
            for (int ai = 0; ai < 2; ++ai)
#pragma unroll
                for (int m = 0; m < 4; ++m) { bf16_t* rowp = BZ + (size_t)(row0 + ai * HALF + m * 16) * 1024 + (pn - 12) * 128 + cl;
                    *(u32x4*)rowp = pack8(acc[ai][0][m][0] * vsilu(acc[ai][1][m][0]), acc[ai][0][m][1] * vsilu(acc[ai][1][m][1])); }
        } else if (pn < 24) {
#pragma unroll
            for (int ai = 0; ai < 2; ++ai)
#pragma unroll
                for (int m = 0; m < 4; ++m) { bf16_t* rowp = SZA + (size_t)(row0 + ai * HALF + m * 16) * 1024 + (pn - 20) * 256 + cl;
#pragma unroll
                    for (int bj = 0; bj < 2; ++bj) *(u32x4*)(rowp + bj * HALF) = pack8(vsilu(acc[ai][bj][m][0]), vsilu(acc[ai][bj][m][1])); }
        } else {
            bf16_t* base = pn < 28 ? SGA + (pn - 24) * 256 : SGB + (pn - 28) * 256;
#pragma unroll
            for (int ai = 0; ai < 2; ++ai)
#pragma unroll
                for (int m = 0; m < 4; ++m) { bf16_t* rowp = base + (size_t)(row0 + ai * HALF + m * 16) * 1024 + cl;
#pragma unroll
                    for (int bj = 0; bj < 2; ++bj) *(u32x4*)(rowp + bj * HALF) = pack8(vsig(acc[ai][bj][m][0]), vsig(acc[ai][bj][m][1])); }
        }
    }
};
struct EpiE {
    static constexpr bool PERM = true, AFTER_DRAIN = false;
    bf16_t* E;
    __device__ __forceinline__ void operator()(const f32x4 (&acc)[2][2][4][2], const Unit& u, int wr, int wc, int fr, int fq) const {
        const int row0 = u.pm * BM + wr * 64 + fr, cl = wc * 32 + 8 * fq;
#pragma unroll
        for (int ai = 0; ai < 2; ++ai)
#pragma unroll
            for (int m = 0; m < 4; ++m) { bf16_t* rowp = E + (size_t)(row0 + ai * HALF + m * 16) * 256 + cl;
#pragma unroll
                for (int bj = 0; bj < 2; ++bj) *(u32x4*)(rowp + bj * HALF) = pack8(acc[ai][bj][m][0], acc[ai][bj][m][1]); }
    }
};
struct EpiY {
    static constexpr bool PERM = true, AFTER_DRAIN = false;
    bf16_t* GY;
    __device__ __forceinline__ void operator()(const f32x4 (&acc)[2][2][4][2], const Unit& u, int wr, int wc, int fr, int fq) const {
        const int g = u.pm >> 2, n0 = (u.pm & 3) * 256 + wr * 64 + fr, oc0 = (u.pn & 1) * 256 + wc * 32 + 8 * fq;
#pragma unroll
        for (int ai = 0; ai < 2; ++ai)
#pragma unroll
            for (int m = 0; m < 4; ++m) { const int n = n0 + ai * HALF + m * 16, b = n >> 7, c = n & 127;
#pragma unroll
                for (int bj = 0; bj < 2; ++bj) { const int oc = oc0 + bj * HALF, i = oc >> 4, h0 = oc & 15; const size_t tok = (size_t)b * 4096 + c * 32 + i;
                    *(u32x4*)(GY + tok * 1024 + g * 16 + h0) = pack8(vgelu(acc[ai][bj][m][0]), vgelu(acc[ai][bj][m][1])); } }
    }
};
struct EpiGLU {
    static constexpr bool PERM = true, AFTER_DRAIN = false;
    const bf16_t *GY, *SZA; bf16_t* YA;
    __device__ __forceinline__ void operator()(const f32x4 (&acc)[2][2][4][2], const Unit& u, int wr, int wc, int fr, int fq) const {
        const int row0 = u.pm * BM + wr * 64 + fr, col0 = u.pn * BM + wc * 32 + 8 * fq;
#pragma unroll
        for (int ai = 0; ai < 2; ++ai)
#pragma unroll
            for (int m = 0; m < 4; ++m) { const size_t off = (size_t)(row0 + ai * HALF + m * 16) * 1024 + col0;
#pragma unroll
                for (int bj = 0; bj < 2; ++bj) { f32x4 g0, g1, z0, z1; unpack8(*(const u32x4*)(GY + off + bj * HALF), g0, g1); unpack8(*(const u32x4*)(SZA + off + bj * HALF), z0, z1);
                    *(u32x4*)(YA + off + bj * HALF) = pack8(g0 * vsig(acc[ai][bj][m][0]) * z0, g1 * vsig(acc[ai][bj][m][1]) * z1); } }
    }
};
template <bool ADD> struct EpiGate {
    static constexpr bool PERM = true, AFTER_DRAIN = false;
    const bf16_t *SG, *PREV; bf16_t* O;
    __device__ __forceinline__ void operator()(const f32x4 (&acc)[2][2][4][2], const Unit& u, int wr, int wc, int fr, int fq) const {
        const int row0 = u.pm * BM + wr * 64 + fr, col0 = u.pn * BM + wc * 32 + 8 * fq;
#pragma unroll
        for (int ai = 0; ai < 2; ++ai)
#pragma unroll
            for (int m = 0; m < 4; ++m) { const size_t off = (size_t)(row0 + ai * HALF + m * 16) * 1024 + col0;
#pragma unroll
                for (int bj = 0; bj < 2; ++bj) { f32x4 s0, s1; unpack8(*(const u32x4*)(SG + off + bj * HALF), s0, s1);
                    f32x4 v0 = s0 * acc[ai][bj][m][0], v1 = s1 * acc[ai][bj][m][1];
                    if (ADD) { f32x4 p0, p1; unpack8(*(const u32x4*)(PREV + off + bj * HALF), p0, p1); v0 += p0; v1 += p1; }
                    *(u32x4*)(O + off + bj * HALF) = pack8(v0, v1); } }
    }
};
struct EpiOut {
    static constexpr bool PERM = false, AFTER_DRAIN = false;
    const float* X; float* O; float* SSQ;
    __device__ __forceinline__ void operator()(const f32x4 (&acc)[2][2][4][2], const Unit& u, int wr, int wc, int fr, int fq) const {
        const int row0 = u.pm * BM + wr * 64 + fr, col0 = u.pn * BM + wc * 32 + 4 * fq;
#pragma unroll
        for (int ai = 0; ai < 2; ++ai)
#pragma unroll
            for (int m = 0; m < 4; ++m) { const int r = row0 + ai * HALF + m * 16; const size_t off = (size_t)r * 1024 + col0; float s = 0.f;
#pragma unroll
                for (int bj = 0; bj < 2; ++bj)
#pragma unroll
                    for (int n = 0; n < 2; ++n) { const f32x4 h = *(const f32x4*)(X + off + bj * HALF + n * 16) + acc[ai][bj][m][n];
                        *(f32x4*)(O + off + bj * HALF + n * 16) = h; s += (h[0] * h[0] + h[1] * h[1]) + (h[2] * h[2] + h[3] * h[3]); }
                s += __shfl_xor(s, 16); s += __shfl_xor(s, 32);
                if (fq == 0) SSQ[(size_t)r * 16 + u.pn * 4 + wc] = s; }
    }
};
struct GroupOrder {
    int per_g, nj, total, G, c;
    __device__ __forceinline__ bool next(int i, Unit& u) const { const int L = i * G + c; if (L >= total) return false; const int g = L / per_g, rem = L - g * per_g, r = rem / nj, j = rem - r * nj; u.pm = g * 4 + r; u.pn = g * nj + j; return true; }
    __device__ __forceinline__ void a_ready(const Unit&) const {}
    __device__ __forceinline__ void done(const Unit&) const {}
};
}

namespace pg8 {
template <class Epi, class Sched>
__device__ __forceinline__ void gemm_phase_ref(const Gemm g, const Sched& S, const Epi& E) {
    const int tid = threadIdx.x, wid = __builtin_amdgcn_readfirstlane(tid >> 6), lane = tid & 63, wr = wid >> 2, wc = wid & 3, fr = lane & 15, fq = lane >> 4;
    Unit u;
    for (int ui = 0; S.next(ui, u); ++ui) {
        f32x4 acc[2][2][4][2];
#pragma unroll
        for (int a = 0; a < 2; ++a)
#pragma unroll
            for (int b = 0; b < 2; ++b)
#pragma unroll
                for (int m = 0; m < 4; ++m)
#pragma unroll
                    for (int n = 0; n < 2; ++n) acc[a][b][m][n] = (f32x4){0.f, 0.f, 0.f, 0.f};
        const bf16_t* Ab = g.A + (size_t)u.pm * 256 * g.lda + (size_t)(wr * 64 + fr) * g.lda;
        const bf16_t* Bb = g.Bt + (size_t)u.pn * 256 * g.ldb + (size_t)(wc * 32) * g.ldb;
        for (int k = 0; k < g.K; k += 8) {
#pragma unroll
            for (int ai = 0; ai < 2; ++ai) {
                f32x4 a0[4], a1[4];
#pragma unroll
                for (int m = 0; m < 4; ++m) unpack8(*(const u32x4*)(Ab + (size_t)(ai * 128 + m * 16) * g.lda + k), a0[m], a1[m]);
#pragma unroll
                for (int bj = 0; bj < 2; ++bj)
#pragma unroll
                    for (int n = 0; n < 2; ++n)
#pragma unroll
                        for (int e = 0; e < 4; ++e) {
                            const int col = bj * 128 + (Epi::PERM ? 8 * fq + 4 * n + e : 16 * n + 4 * fq + e);
                            f32x4 b0, b1; unpack8(*(const u32x4*)(Bb + (size_t)col * g.ldb + k), b0, b1);
#pragma unroll
                            for (int m = 0; m < 4; ++m) { const f32x4 p = a0[m] * b0 + a1[m] * b1; acc[ai][bj][m][n][e] += (p[0] + p[1]) + (p[2] + p[3]); }
                        }
                asm volatile("" ::: "memory");
            }
        }
        E(acc, u, wr, wc, fr, fq);
    }
}
}
#ifndef REFMASK
#define REFMASK 0x0
#endif
#define RUN_GEMM(PH, EPI, SCHED, g, S, Ep) do { if constexpr ((REFMASK >> (PH)) & 1) pg8::gemm_phase_ref<EPI, SCHED>(g, S, Ep); else pg8::gemm_phase<EPI, SCHED, true, true>(lds, g, S, Ep); } while (0)
constexpr int NWAVES = 8, NTHR = 512;
constexpr int M = 32768, D = 1024, SEQ = 4096, NIN = 8192, NG = 64, KA = 768;
constexpr float EPS = 1e-6f;
constexpr size_t MiB = 1u << 20;
constexpr size_t WS_AT = 0, WS_SSQ = 1 * MiB, WS_WIN = 4 * MiB, WS_WGLU = 20 * MiB, WS_WA = 22 * MiB, WS_WB = 24 * MiB, WS_WOUT = 26 * MiB, WS_PT = 28 * MiB, WS_MQT = 44 * MiB;
constexpr size_t WS_XN = 96 * MiB  , WS_ACAT = 160 * MiB  , WS_E = 256 * MiB  ;
constexpr size_t WS_CV = 288 * MiB  , WS_BZ = 352 * MiB  , WS_YB = 416 * MiB  , WS_END = 480 * MiB;
constexpr int LDS_BYTES = 147456;
#define LAS __attribute__((address_space(3)))
typedef unsigned short bf16;
typedef unsigned v4u __attribute__((ext_vector_type(4)));
typedef float f32x4 __attribute__((ext_vector_type(4)));
#define LDS_WAIT() asm volatile("s_waitcnt lgkmcnt(0)" ::: "memory")
__device__ __forceinline__ unsigned pk2(float lo, float hi) { return pg8::cvt_pk_bf16(lo, hi); }
__device__ __forceinline__ float wave_sum(float v) {
#pragma unroll
    for (int o = 1; o < 64; o <<= 1) v += __shfl_xor(v, o);
    return v;
}
__device__ __forceinline__ int win_src(int j) {
    const int pn = j >> 8, jj = j & 255;
    if (pn < 4) return pn * 256 + jj;
    if (pn < 12) { const int q = pn - 4; return jj < 128 ? 2048 + q * 128 + jj : 4096 + q * 128 + (jj - 128); }
    if (pn < 20) { const int q = pn - 12; return jj < 128 ? 3072 + q * 128 + jj : 5120 + q * 128 + (jj - 128); }
    if (pn < 24) return 1024 + (pn - 20) * 256 + jj;
    if (pn < 28) return 6144 + (pn - 24) * 256 + jj;
    return 7168 + (pn - 28) * 256 + jj;
}
__device__ __forceinline__ void p0_transpose_item(const float* W, int ldw, int src_col0, bf16* WT, int K, int dst_row0, int k0, LAS float* scr, int lane) {
#pragma unroll 8
    for (int i = 0; i < 32; ++i) { const int kk = 2 * i + (lane >> 5); scr[kk * 33 + (lane & 31)] = W[(size_t)(k0 + kk) * ldw + src_col0 + (lane & 31)]; }
    LDS_WAIT(); asm volatile("" ::: "memory");
    const int c = lane & 7;
#pragma unroll
    for (int j = 0; j < 4; ++j) { const int n = (lane >> 3) + 8 * j; const LAS float* s = scr + (8 * c) * 33 + n;
        v4u o; o.x = pk2(s[0 * 33], s[1 * 33]); o.y = pk2(s[2 * 33], s[3 * 33]); o.z = pk2(s[4 * 33], s[5 * 33]); o.w = pk2(s[6 * 33], s[7 * 33]);
        *(v4u*)(WT + (size_t)(dst_row0 + n) * K + k0 + 8 * c) = o; }
    LDS_WAIT(); asm volatile("" ::: "memory");
}
struct Args { const float* in[18]; float* out; unsigned char* ws; int ph_lo, ph_hi; };

__device__ __forceinline__ void p0_ssm_setup(const Args& a, LAS unsigned char* lds, int g, int q, int tid) {
    const float *lam_re = a.in[3], *lam_im = a.in[4], *log_dt = a.in[5], *b_re = a.in[6], *b_im = a.in[7], *c_re = a.in[8], *c_im = a.in[9], *ssm_d = a.in[10];
    LAS float* Apow = (LAS float*)lds;
    LAS float* Bb = Apow + 8704;
    LAS float* Cc = Bb + 4096;
    LAS float* Kt = Cc + 4096;
    bf16* MQt = (bf16*)(a.ws + WS_MQT); bf16* Pt = (bf16*)(a.ws + WS_PT); float* ATt = (float*)(a.ws + WS_AT);
    if (tid < 128) {
        const int dir = tid >> 6, p = tid & 63, gi = dir * 64 + g;
        const float dt = expf(log_dt[gi]), lr = lam_re[gi * 64 + p], li = lam_im[gi * 64 + p];
        const float mag = expf(lr * dt), th = li * dt, k = rintf(th * 0.15915494309f);
        float r = fmaf(-k, 6.2831854820251465f, th); r = fmaf(-k, -1.7484555e-7f, r);
        const float Ar = mag * cosf(r), Ai = mag * sinf(r);
        float pr = 1.f, pi = 0.f; const int base = (dir * 64 + p) * 34;
        for (int d = 0; d <= 32; ++d) { Apow[(base + d) * 2] = pr; Apow[(base + d) * 2 + 1] = pi; const float nr_ = pr * Ar - pi * Ai, ni_ = pr * Ai + pi * Ar; pr = nr_; pi = ni_; }
        const float den = lr * lr + li * li, nr = Ar - 1.0f, ni = Ai, cr = (nr * lr + ni * li) / den, ci = (ni * lr - nr * li) / den;
        for (int h = 0; h < 16; ++h) { const float br = b_re[(gi * 64 + p) * 16 + h], bi = b_im[(gi * 64 + p) * 16 + h];
            Bb[((dir * 64 + p) * 16 + h) * 2] = cr * br - ci * bi; Bb[((dir * 64 + p) * 16 + h) * 2 + 1] = cr * bi + ci * br; }
    }
    for (int idx = tid; idx < 2048; idx += NTHR) { const int dir = idx >> 10, rem = idx & 1023; Cc[idx * 2] = c_re[(dir * 64 + g) * 1024 + rem]; Cc[idx * 2 + 1] = c_im[(dir * 64 + g) * 1024 + rem]; }
    __syncthreads();
    {
        const int hh = tid & 255, h = hh >> 4, hp = hh & 15, dir = tid >> 8;
        float acc[32];
#pragma unroll
        for (int d = 0; d < 32; ++d) acc[d] = 0.f;
        for (int p = 0; p < 64; ++p) {
            const float Cr = Cc[((dir * 16 + h) * 64 + p) * 2], Ci = Cc[((dir * 16 + h) * 64 + p) * 2 + 1], Br = Bb[((dir * 64 + p) * 16 + hp) * 2], Bi = Bb[((dir * 64 + p) * 16 + hp) * 2 + 1];
            const float Wr = Cr * Br - Ci * Bi, Wi = Cr * Bi + Ci * Br;
            const LAS float* ap = Apow + (dir * 64 + p) * 68;
#pragma unroll
            for (int d = 0; d < 32; ++d) acc[d] += Wr * ap[2 * d] - Wi * ap[2 * d + 1];
        }
#pragma unroll
        for (int d = 0; d < 32; ++d) Kt[((dir * 32 + d) * 16 + h) * 16 + hp] = acc[d];
    }
    __syncthreads();
    for (int idx = tid; idx < 128 * 96; idx += NTHR) {
        const int rowl = idx / 96, ch = idx - rowl * 96, i = 8 * q + (rowl >> 4), h = rowl & 15;
        float v[8];
        if (ch < 64) {
            const int j = ch >> 1, h0 = (ch & 1) * 8;
            if (j != i) { const LAS float* src = Kt + (((j < i ? (i - j) : 32 + (j - i)) * 16 + h) * 16 + h0);
#pragma unroll
                for (int k = 0; k < 8; ++k) v[k] = src[k];
            } else { const LAS float* s0 = Kt + (h * 16 + h0); const LAS float* s1 = Kt + ((32 * 16 + h) * 16 + h0); const float dv = ssm_d[g * 16 + h];
#pragma unroll
                for (int k = 0; k < 8; ++k) v[k] = s0[k] + s1[k] + ((h0 + k) == h ? dv : 0.f);
            }
        } else {
            const int sc0 = (ch - 64) * 8, dir = sc0 >> 7, p0 = (sc0 & 127) >> 1, e = dir ? 32 - i : i + 1;
#pragma unroll
            for (int k = 0; k < 4; ++k) { const int p = p0 + k; const float Ar = Apow[((dir * 64 + p) * 34 + e) * 2], Ai = Apow[((dir * 64 + p) * 34 + e) * 2 + 1];
                const float Cr = Cc[((dir * 16 + h) * 64 + p) * 2], Ci = Cc[((dir * 16 + h) * 64 + p) * 2 + 1];
                v[2 * k] = Cr * Ar - Ci * Ai; v[2 * k + 1] = -(Cr * Ai + Ci * Ar); }
        }
        v4u o; o.x = pk2(v[0], v[1]); o.y = pk2(v[2], v[3]); o.z = pk2(v[4], v[5]); o.w = pk2(v[6], v[7]);
        *(v4u*)(MQt + ((size_t)(g * 512 + i * 16 + h) * KA + ch * 8)) = o;
    }
    for (int idx = tid; idx < 64 * 64; idx += NTHR) {
        const int scl = idx >> 6, ch = idx & 63, sc = 64 * q + scl, dir = sc >> 7, p = (sc & 127) >> 1, ri = sc & 1, j = ch >> 1, h0 = (ch & 1) * 8, e = dir ? j : 31 - j;
        const float Ar = Apow[((dir * 64 + p) * 34 + e) * 2], Ai = Apow[((dir * 64 + p) * 34 + e) * 2 + 1];
        float v[8];
#pragma unroll
        for (int k = 0; k < 8; ++k) { const float Br = Bb[((dir * 64 + p) * 16 + h0 + k) * 2], Bi = Bb[((dir * 64 + p) * 16 + h0 + k) * 2 + 1]; v[k] = ri ? (Ar * Bi + Ai * Br) : (Ar * Br - Ai * Bi); }
        v4u o; o.x = pk2(v[0], v[1]); o.y = pk2(v[2], v[3]); o.z = pk2(v[4], v[5]); o.w = pk2(v[6], v[7]);
        *(v4u*)(Pt + ((size_t)(g * 256 + sc) * 512 + ch * 8)) = o;
    }
    if (q == 0 && tid < 128) { const int dir = tid >> 6, p = tid & 63; ATt[((g * 2 + dir) * 64 + p) * 2] = Apow[((dir * 64 + p) * 34 + 32) * 2]; ATt[((g * 2 + dir) * 64 + p) * 2 + 1] = Apow[((dir * 64 + p) * 34 + 32) * 2 + 1]; }
    __syncthreads();
}

__global__ void __launch_bounds__(NTHR, 2) s5conv_fwd(Args a) {
    extern __shared__ __attribute__((aligned(16))) unsigned char lds_raw[];
    LAS unsigned char* lds = (LAS unsigned char*)lds_raw;
    cg::grid_group grid = cg::this_grid();
    const int tid = threadIdx.x, lane = tid & 63, wave = __builtin_amdgcn_readfirstlane(tid >> 6);
    const int G = gridDim.x, bx = blockIdx.x;
    const int gw = bx * NWAVES + wave, NGW = G * NWAVES;
    unsigned char* ws = a.ws;
    bf16 *WinT = (bf16*)(ws + WS_WIN), *WgluT = (bf16*)(ws + WS_WGLU), *WaT = (bf16*)(ws + WS_WA), *WbT = (bf16*)(ws + WS_WB), *WoutT = (bf16*)(ws + WS_WOUT);
    bf16 *Pt = (bf16*)(ws + WS_PT), *MQt = (bf16*)(ws + WS_MQT), *XN = (bf16*)(ws + WS_XN), *YA = (bf16*)(ws + WS_XN), *MG = (bf16*)(ws + WS_XN), *ACAT = (bf16*)(ws + WS_ACAT), *E = (bf16*)(ws + WS_E);
    bf16 *SZA = (bf16*)(ws + WS_ACAT), *SGB = (bf16*)(ws + WS_ACAT + 64 * MiB), *CV = (bf16*)(ws + WS_CV), *GY = (bf16*)(ws + WS_CV), *OA = (bf16*)(ws + WS_CV), *BZ = (bf16*)(ws + WS_BZ), *SGA = (bf16*)(ws + WS_BZ), *YB = (bf16*)(ws + WS_YB);
    float* SSQ = (float*)(ws + WS_SSQ);
    const int lo = a.ph_lo, hi = a.ph_hi;
#define IN(k) (lo <= (k) && (k) < hi)
#define SEAM(k) do { if (IN(k) && IN((k) + 1)) grid.sync(); } while (0)

    if (IN(0)) {
        for (int u = bx; u < NG * 4; u += G) p0_ssm_setup(a, lds, u >> 2, u & 3, tid);
        LAS float* scr = (LAS float*)(lds + wave * 16384);
        for (int it = gw; it < 4096 + 4 * 512; it += NGW) {
            if (it < 4096) { const int kb = it >> 8, nb = it & 255; p0_transpose_item(a.in[2], NIN, win_src(nb * 32), WinT, D, nb * 32, kb * 64, scr, lane); }
            else { const int r = it - 4096, w = r >> 9, kb = (r & 511) >> 5, nb = r & 31;
                const float* W = w == 0 ? a.in[11] : w == 1 ? a.in[14] : w == 2 ? a.in[15] : a.in[16]; bf16* WT = w == 0 ? WgluT : w == 1 ? WaT : w == 2 ? WbT : WoutT;
                p0_transpose_item(W, D, nb * 32, WT, D, nb * 32, kb * 64, scr, lane); }
        }
        const float* ng = a.in[1];
        f32x4 gv[4];
#pragma unroll
        for (int j = 0; j < 4; ++j) gv[j] = *((const f32x4*)ng + lane + 64 * j);
        for (int m = gw; m < M; m += NGW) {
            const f32x4* xr = (const f32x4*)(a.in[0] + (size_t)m * D) + lane; f32x4 v[4]; float s = 0.f;
#pragma unroll
            for (int j = 0; j < 4; ++j) { v[j] = xr[64 * j]; s += (v[j].x * v[j].x + v[j].y * v[j].y) + (v[j].z * v[j].z + v[j].w * v[j].w); }
            const float rs = 1.0f / sqrtf(wave_sum(s) * (1.f / D) + EPS);
            unsigned long long* o8 = (unsigned long long*)(XN + (size_t)m * D) + lane;
#pragma unroll
            for (int j = 0; j < 4; ++j) { const f32x4 t = v[j] * rs * gv[j]; o8[64 * j] = (unsigned long long)pk2(t.x, t.y) | ((unsigned long long)pk2(t.z, t.w) << 32); }
        }
    }
    SEAM(0);
    if (IN(1)) {
        pg8::Gemm g{XN, WinT, D, D, D}; pg8::StaticOrder S; S.init(M, 20 * 256, G, bx);
        pg8::EpiP1 Ep{ACAT, SZA, CV, BZ, SGA, SGB, 0};
        RUN_GEMM(1, pg8::EpiP1, pg8::StaticOrder, g, S, Ep);
    }
    SEAM(1);
    if (IN(2)) {
        pg8::Gemm g{ACAT, Pt, KA, 512, 512}; pg8::GroupOrder S{4, 1, NG * 4, G, bx};
        pg8::EpiE Ep{E};
        RUN_GEMM(2, pg8::EpiE, pg8::GroupOrder, g, S, Ep);
    }
    SEAM(2);
    if (IN(3)) {
        const float* ATt = (const float*)(ws + WS_AT);
        for (int w = gw; w < NG * 8 * 2; w += NGW) {
            const int g = w >> 4, b = (w >> 1) & 7, dir = w & 1, p = lane;
            const float ar = ATt[((g * 2 + dir) * 64 + p) * 2], ai = ATt[((g * 2 + dir) * 64 + p) * 2 + 1];
            const size_t n0 = (size_t)g * 1024 + b * 128;
            const unsigned* Ep = (const unsigned*)(E + n0 * 256 + dir * 128) + p;
            unsigned* Sp = (unsigned*)(ACAT + n0 * KA + 512 + dir * 128) + p;
            float sr = 0.f, si = 0.f;
            if (dir == 0) {
                Sp[0] = 0u;
#pragma unroll 8
                for (int c = 0; c < 127; ++c) { const unsigned e = Ep[(size_t)c * 128]; const float er = __uint_as_float(e << 16), ei = __uint_as_float(e & 0xffff0000u);
                    const float nr = ar * sr - ai * si + er, ni = ar * si + ai * sr + ei; sr = nr; si = ni; Sp[(size_t)(c + 1) * 384] = pk2(sr, si); }
            } else {
                Sp[(size_t)127 * 384] = 0u;
#pragma unroll 8
                for (int c = 127; c > 0; --c) { const unsigned e = Ep[(size_t)c * 128]; const float er = __uint_as_float(e << 16), ei = __uint_as_float(e & 0xffff0000u);
                    const float nr = ar * sr - ai * si + er, ni = ar * si + ai * sr + ei; sr = nr; si = ni; Sp[(size_t)(c - 1) * 384] = pk2(sr, si); }
            }
        }
        {
            const int gt = bx * NTHR + tid, ch = gt & 127; const float *cw = a.in[12], *cb = a.in[13];
            f32x4 w0[2], w1[2], w2[2], bb[2];
#pragma unroll
            for (int k = 0; k < 2; ++k) { w0[k] = *(const f32x4*)(cw + ch * 8 + 4 * k); w1[k] = *(const f32x4*)(cw + D + ch * 8 + 4 * k); w2[k] = *(const f32x4*)(cw + 2 * D + ch * 8 + 4 * k); bb[k] = *(const f32x4*)(cb + ch * 8 + 4 * k); }
            for (int it = gt; it < M * 128; it += G * NTHR) {
                const int r = it >> 7, t = r & (SEQ - 1); const size_t off = (size_t)r * D + ch * 8;
                f32x4 c0a, c0b, c1a, c1b, c2a, c2b, za, zb;
                const v4u zero = (v4u){0u, 0u, 0u, 0u};
                pg8::unpack8(t > 0 ? *(const v4u*)(CV + off - D) : zero, c0a, c0b); pg8::unpack8(*(const v4u*)(CV + off), c1a, c1b); pg8::unpack8(t < SEQ - 1 ? *(const v4u*)(CV + off + D) : zero, c2a, c2b);
                pg8::unpack8(*(const v4u*)(BZ + off), za, zb);
                const f32x4 ya = za * (bb[0] + w0[0] * c0a + w1[0] * c1a + w2[0] * c2a), yb = zb * (bb[1] + w0[1] * c0b + w1[1] * c1b + w2[1] * c2b);
                *(v4u*)(YB + off) = pg8::pack8(ya, yb);
            }
        }
    }
    SEAM(3);
    if (IN(4)) {
        pg8::Gemm g{ACAT, MQt, KA, KA, KA}; pg8::GroupOrder S{8, 2, NG * 8, G, bx};
        pg8::EpiY Ep{GY};
        RUN_GEMM(4, pg8::EpiY, pg8::GroupOrder, g, S, Ep);
    }
    SEAM(4);
    if (IN(5)) {
        pg8::Gemm g{XN, WinT + (size_t)20 * 256 * D, D, D, D}; pg8::StaticOrder S; S.init(M, 12 * 256, G, bx);
        pg8::EpiP1 Ep{ACAT, SZA, CV, BZ, SGA, SGB, 20};
        RUN_GEMM(5, pg8::EpiP1, pg8::StaticOrder, g, S, Ep);
    }
    SEAM(5);
    if (IN(6)) {
        pg8::Gemm g{GY, WgluT, D, D, D}; pg8::StaticOrder S; S.init(M, D, G, bx);
        pg8::EpiGLU Ep{GY, SZA, YA};
        RUN_GEMM(6, pg8::EpiGLU, pg8::StaticOrder, g, S, Ep);
    }
    SEAM(6);
    if (IN(7)) {
        pg8::Gemm g{YA, WaT, D, D, D}; pg8::StaticOrder S; S.init(M, D, G, bx);
        pg8::EpiGate<false> Ep{SGA, nullptr, OA};
        RUN_GEMM(7, pg8::EpiGate<false>, pg8::StaticOrder, g, S, Ep);
    }
    SEAM(7);
    if (IN(8)) {
        pg8::Gemm g{YB, WbT, D, D, D}; pg8::StaticOrder S; S.init(M, D, G, bx);
        pg8::EpiGate<true> Ep{SGB, OA, MG};
        RUN_GEMM(8, pg8::EpiGate<true>, pg8::StaticOrder, g, S, Ep);
    }
    SEAM(8);
    if (IN(9)) {
        pg8::Gemm g{MG, WoutT, D, D, D}; pg8::StaticOrder S; S.init(M, D, G, bx);
        pg8::EpiOut Ep{a.in[0], a.out, SSQ};
        RUN_GEMM(9, pg8::EpiOut, pg8::StaticOrder, g, S, Ep);
    }
    SEAM(9);
    if (IN(10)) {
        const float* fg = a.in[17];
        f32x4 gv[4];
#pragma unroll
        for (int j = 0; j < 4; ++j) gv[j] = *((const f32x4*)fg + lane + 64 * j);
        for (int m = gw; m < M; m += NGW) {
            float s = SSQ[(size_t)m * 16 + (lane & 15)];
            s += __shfl_xor(s, 1); s += __shfl_xor(s, 2); s += __shfl_xor(s, 4); s += __shfl_xor(s, 8);
            const float rs = 1.0f / sqrtf(s * (1.f / D) + EPS);
            f32x4* hr = (f32x4*)(a.out + (size_t)m * D) + lane;
#pragma unroll
            for (int j = 0; j < 4; ++j) hr[64 * j] = hr[64 * j] * rs * gv[j];
        }
    }
#undef IN
#undef SEAM
}

#ifndef MK_PER_PHASE
#define MK_PER_PHASE 0
#endif
constexpr int N_PHASES = 11;
extern "C" void kernel_launch(void* const* d_in, const int* in_sizes, int n_in, void* d_out, int out_size, void* d_ws, size_t ws_size, hipStream_t stream) {
    static int grid = 0;
    if (grid == 0) {
        if (n_in != 18 || in_sizes[0] != M * D || out_size != M * D || ws_size < WS_END) { fprintf(stderr, "kernel_launch: unexpected shapes (n_in %d, in0 %d, out %d, ws %zu)\n", n_in, n_in > 0 ? in_sizes[0] : -1, out_size, ws_size); grid = -1; return; }
        int dev = 0, cus = 0, per_cu = 0;
        if (hipGetDevice(&dev) != hipSuccess || hipDeviceGetAttribute(&cus, hipDeviceAttributeMultiprocessorCount, dev) != hipSuccess) { grid = -1; return; }
        if (hipFuncSetAttribute((const void*)s5conv_fwd, hipFuncAttributeMaxDynamicSharedMemorySize, LDS_BYTES) != hipSuccess) { fprintf(stderr, "kernel_launch: hipFuncSetAttribute failed\n"); grid = -1; return; }
        if (hipOccupancyMaxActiveBlocksPerMultiprocessor(&per_cu, (const void*)s5conv_fwd, NTHR, LDS_BYTES) != hipSuccess || per_cu < 1) { fprintf(stderr, "kernel_launch: occupancy query says %d\n", per_cu); per_cu = 1; }
        (void)hipGetLastError();
        grid = cus * 1;
    }
    if (grid < 0) return;
    Args a{};
    for (int i = 0; i < 18; ++i) a.in[i] = (const float*)d_in[i];
    a.out = (float*)d_out; a.ws = (unsigned char*)d_ws;
#if MK_PER_PHASE
    for (int ph = 0; ph < N_PHASES; ++ph) { a.ph_lo = ph; a.ph_hi = ph + 1; hipLaunchKernelGGL(s5conv_fwd, dim3(grid), dim3(NTHR), LDS_BYTES, stream, a); }
#else
    a.ph_lo = 0; a.ph_hi = N_PHASES;
    void* args[] = {&a};
    hipError_t e = hipLaunchCooperativeKernel((const void*)s5conv_fwd, dim3(grid), dim3(NTHR), args, LDS_BYTES, stream);
    if (e != hipSuccess) fprintf(stderr, "kernel_launch: cooperative launch failed: %s (grid %d)\n", hipGetErrorString(e), grid);
#endif
}
```

```cpp
#include <hip/hip_runtime.h>
#include <hip/hip_cooperative_groups.h>
#include <cstdio>
#include <cstdint>
namespace cg = cooperative_groups;
namespace pg8 {
#define PG8_LAS __attribute__((address_space(3)))
typedef unsigned short bf16_t;
typedef short bf16x8 __attribute__((ext_vector_type(8)));
typedef float f32x4 __attribute__((ext_vector_type(4)));
typedef unsigned u32x4 __attribute__((ext_vector_type(4)));
constexpr int BM = 256, BK = 64, HALF = 128, HTB = HALF * BK * 2  , STAGE_BYTES = 8 * HTB, NXCD = 8, WGM = 8;

__host__ __device__ __forceinline__ int lds_byte(int r, int c) { const int st = (r >> 4) * 2 + (c >> 5), rr = r & 15, cc = c & 31, ob = rr * 64 + cc * 2; return st * 1024 + (ob ^ (((ob >> 9) & 1) << 5)); }
__host__ __device__ __forceinline__ void stage_rc(int b, int& R, int& C) { const int st = b / 1024, sb = b % 1024, swz = sb ^ (((sb >> 9) & 1) << 5); R = (st >> 1) * 16 + swz / 64; C = (st & 1) * 32 + (swz % 64) / 2; }
__host__ __device__ __forceinline__ int perm32(int rho) { const int n = rho >> 4, i = rho & 15; return 8 * (i >> 2) + 4 * n + (i & 3); }

struct Unit { int pm, pn; };
struct Gemm { const bf16_t* A; const bf16_t* Bt; int lda, ldb, K; };

struct StaticOrder {
    int nM, nN, nwg, G, c;
    __host__ __device__ void init(int M, int N, int G_, int c_) { nM = M / BM; nN = N / BM; nwg = nM * nN; G = G_; c = c_; }
    __host__ __device__ bool next(int i, Unit& u) const {
        const long L = (long)i * G + c; if (L >= nwg) return false;
        int wgid = (int)L; { const int q = nwg / NXCD, r = nwg % NXCD, xcd = wgid % NXCD, off = wgid / NXCD; wgid = (xcd < r ? xcd * (q + 1) : r * (q + 1) + (xcd - r) * q) + off; }
        const int nig = WGM * nN, gid = wgid / nig, fm = gid * WGM, gsz = (nM - fm) < WGM ? (nM - fm) : WGM;
        u.pm = fm + ((wgid % nig) % gsz); u.pn = (wgid % nig) / gsz; return true;
    }
    __device__ __forceinline__ void a_ready(const Unit&) const {}
    __device__ __forceinline__ void done(const Unit&) const {}
};

template <class Epi, class Sched, bool ALIGN_EPI = false, bool SP2 = false>
__device__ __forceinline__ void gemm_phase(PG8_LAS unsigned char* lds, const Gemm g, const Sched& S, const Epi& E) {
    const int tid = threadIdx.x, wid = __builtin_amdgcn_readfirstlane(tid >> 6), lane = tid & 63, wr = wid >> 2, wc = wid & 3, fr = lane & 15, fq = lane >> 4;
    const int K = g.K, nt = K / BK;
    unsigned voffA[2], voffB[2];
#pragma unroll
    for (int i = 0; i < 2; ++i) { int R, C; stage_rc(tid * 16 + i * 8192, R, C); const int Rb = Epi::PERM ? ((R & ~31) + perm32(R & 31)) : R;
        voffA[i] = (unsigned)(R * g.lda + C) * 2u; voffB[i] = (unsigned)(Rb * g.ldb + C) * 2u; }
    const size_t kstep = (size_t)(BK * 2);
    const size_t hstepA = (size_t)HALF * g.lda * 2, hstepB = (size_t)HALF * g.ldb * 2;
    const size_t tstepA = 2 * hstepA, tstepB = 2 * hstepB;
    const unsigned ldsw = (unsigned)wid * 1024u;
    const int aoff = lds_byte(wr * 64 + fr, fq * 8), boff = lds_byte(wc * 32 + fr, fq * 8);
#define PG8_SA(b, h) (((b) * 2 + (h)) * HTB)
#define PG8_SB(b, h) ((4 + (b) * 2 + (h)) * HTB)
#define PG8_STAGE(bufoff, gbase, voff) do { _Pragma("unroll") for (int _i = 0; _i < 2; ++_i) \
        __builtin_amdgcn_global_load_lds((const unsigned*)((const char*)(gbase) + (voff)[_i]), (PG8_LAS unsigned*)(lds + (bufoff) + ldsw + _i * 8192), 16, 0, 0); } while (0)
#define PG8_LDA(dst, b, h) do { _Pragma("unroll") for (int m = 0; m < 4; ++m) _Pragma("unroll") for (int k = 0; k < 2; ++k) dst[m][k] = *(const PG8_LAS bf16x8*)(lds + PG8_SA(b, h) + aoff + m * 2048 + k * 1024); } while (0)
#define PG8_LDB(dst, b, h) do { _Pragma("unroll") for (int n = 0; n < 2; ++n) _Pragma("unroll") for (int k = 0; k < 2; ++k) dst[n][k] = *(const PG8_LAS bf16x8*)(lds + PG8_SB(b, h) + boff + n * 2048 + k * 1024); } while (0)
#define PG8_MMA(ai, bj, At, Bt) do { __builtin_amdgcn_s_setprio(1); _Pragma("unroll") for (int m = 0; m < 4; ++m) _Pragma("unroll") for (int n = 0; n < 2; ++n) _Pragma("unroll") for (int k = 0; k < 2; ++k) \
        acc[ai][bj][m][n] = __builtin_amdgcn_mfma_f32_16x16x32_bf16(Bt[n][k], At[m][k], acc[ai][bj][m][n], 0, 0, 0); __builtin_amdgcn_s_setprio(0); } while (0)
#define PG8_WAIT_V(n) asm volatile("s_waitcnt vmcnt(" #n ")" ::: "memory")
#define PG8_WAIT_L(n) asm volatile("s_waitcnt lgkmcnt(" #n ")" ::: "memory")
#define PG8_BAR __builtin_amdgcn_s_barrier()
#define PG8_SCHED __builtin_amdgcn_sched_barrier(0)
    Unit cur, nxt; int ui = 0;
    if (!S.next(0, cur)) return;
    f32x4 acc[2][2][4][2];
#pragma unroll
    for (int a = 0; a < 2; ++a)
#pragma unroll
        for (int b = 0; b < 2; ++b)
#pragma unroll
            for (int m = 0; m < 4; ++m)
#pragma unroll
                for (int n = 0; n < 2; ++n) acc[a][b][m][n] = (f32x4){0.f, 0.f, 0.f, 0.f};
    bf16x8 At[4][2], B0[2][2], B1[2][2];
    const char* cA = (const char*)g.A + (size_t)cur.pm * tstepA; const char* cB = (const char*)g.Bt + (size_t)cur.pn * tstepB;
    S.a_ready(cur);
    if constexpr (SP2) {
        PG8_STAGE(PG8_SB(0, 0), cB, voffB); PG8_STAGE(PG8_SB(0, 1), cB + hstepB, voffB); PG8_STAGE(PG8_SA(0, 0), cA, voffA); PG8_STAGE(PG8_SA(0, 1), cA + hstepA, voffA);
        if (wr == 1) PG8_BAR;
        PG8_WAIT_V(2); PG8_BAR;
        PG8_STAGE(PG8_SB(1, 0), cB + kstep, voffB); PG8_STAGE(PG8_SA(1, 0), cA + kstep, voffA); PG8_STAGE(PG8_SB(1, 1), cB + hstepB + kstep, voffB);
        PG8_WAIT_V(6); PG8_BAR;
    } else {
        PG8_STAGE(PG8_SB(0, 0), cB, voffB); PG8_STAGE(PG8_SA(0, 0), cA, voffA); PG8_STAGE(PG8_SB(0, 1), cB + hstepB, voffB); PG8_STAGE(PG8_SA(0, 1), cA + hstepA, voffA);
        if (wr == 1) PG8_BAR;
        PG8_WAIT_V(4); PG8_BAR;
        PG8_STAGE(PG8_SB(1, 0), cB + kstep, voffB); PG8_STAGE(PG8_SA(1, 0), cA + kstep, voffA); PG8_STAGE(PG8_SB(1, 1), cB + hstepB + kstep, voffB);
        PG8_WAIT_V(6); PG8_BAR;
    }
    for (;;) {
        const bool has_next = S.next(ui + 1, nxt);
        const char* nA = has_next ? (const char*)g.A + (size_t)nxt.pm * tstepA : cA; const char* nB = has_next ? (const char*)g.Bt + (size_t)nxt.pn * tstepB : cB;
        for (int t = 0; t < nt; t += 2) {
            const bool last = (t == nt - 2);
            const char* a1 = cA + (size_t)(t + 1) * kstep;
            const char* a2 = last ? nA : cA + (size_t)(t + 2) * kstep; const char* b2 = last ? nB : cB + (size_t)(t + 2) * kstep;
            const char* a3 = a2 + kstep; const char* b3 = b2 + kstep;
            if (last && has_next) S.a_ready(nxt);
            if constexpr (SP2) {
            PG8_LDB(B0, 0, 0); PG8_LDB(B1, 0, 1); PG8_SCHED; PG8_LDA(At, 0, 0); PG8_STAGE(PG8_SA(1, 1), a1 + hstepA, voffA);
            PG8_WAIT_V(8); PG8_WAIT_L(0); PG8_BAR; PG8_MMA(0, 0, At, B0); PG8_MMA(0, 1, At, B1); PG8_BAR; PG8_SCHED;
            PG8_LDA(At, 0, 1); PG8_STAGE(PG8_SB(0, 0), b2, voffB); PG8_STAGE(PG8_SB(0, 1), b2 + hstepB, voffB); PG8_STAGE(PG8_SA(0, 0), a2, voffA);
            PG8_WAIT_V(8); PG8_WAIT_L(0); PG8_BAR; PG8_MMA(1, 0, At, B0); PG8_MMA(1, 1, At, B1); PG8_BAR; PG8_SCHED;
            PG8_LDB(B0, 1, 0); PG8_LDB(B1, 1, 1); PG8_SCHED; PG8_LDA(At, 1, 0); PG8_STAGE(PG8_SA(0, 1), a2 + hstepA, voffA);
            PG8_WAIT_V(8); PG8_WAIT_L(0); PG8_BAR; PG8_MMA(0, 0, At, B0); PG8_MMA(0, 1, At, B1); PG8_BAR; PG8_SCHED;
            PG8_LDA(At, 1, 1); PG8_STAGE(PG8_SB(1, 0), b3, voffB); PG8_STAGE(PG8_SB(1, 1), b3 + hstepB, voffB); PG8_STAGE(PG8_SA(1, 0), a3, voffA);
            PG8_WAIT_V(8); PG8_WAIT_L(0); PG8_BAR; PG8_MMA(1, 0, At, B0); PG8_MMA(1, 1, At, B1); PG8_BAR; PG8_SCHED;
            } else {
            PG8_LDB(B0, 0, 0); PG8_SCHED; PG8_LDA(At, 0, 0); PG8_STAGE(PG8_SA(1, 1), a1 + hstepA, voffA);
            PG8_WAIT_L(8); PG8_BAR; PG8_WAIT_L(0); PG8_MMA(0, 0, At, B0); PG8_BAR; PG8_SCHED;
            PG8_LDB(B1, 0, 1); PG8_STAGE(PG8_SB(0, 0), b2, voffB);
            PG8_BAR; PG8_WAIT_L(0); PG8_MMA(0, 1, At, B1); PG8_BAR;
            PG8_LDA(At, 0, 1); PG8_STAGE(PG8_SA(0, 0), a2, voffA);
            PG8_BAR; PG8_WAIT_L(0); PG8_MMA(1, 0, At, B0); PG8_BAR; PG8_SCHED;
            PG8_STAGE(PG8_SB(0, 1), b2 + hstepB, voffB);
            PG8_WAIT_V(6); PG8_BAR; PG8_MMA(1, 1, At, B1); PG8_BAR;
            PG8_LDB(B0, 1, 0); PG8_SCHED; PG8_LDA(At, 1, 0); PG8_STAGE(PG8_SA(0, 1), a2 + hstepA, voffA);
            PG8_WAIT_L(8); PG8_BAR; PG8_WAIT_L(0); PG8_MMA(0, 0, At, B0); PG8_BAR; PG8_SCHED;
            PG8_LDB(B1, 1, 1); PG8_STAGE(PG8_SB(1, 0), b3, voffB);
            PG8_BAR; PG8_WAIT_L(0); PG8_MMA(0, 1, At, B1); PG8_BAR;
            PG8_LDA(At, 1, 1); PG8_STAGE(PG8_SA(1, 0), a3, voffA);
            PG8_BAR; PG8_WAIT_L(0); PG8_MMA(1, 0, At, B0); PG8_BAR; PG8_SCHED;
            PG8_STAGE(PG8_SB(1, 1), b3 + hstepB, voffB);
            PG8_WAIT_V(6); PG8_BAR; PG8_MMA(1, 1, At, B1); PG8_BAR;
            }
        }
        if constexpr (ALIGN_EPI) { if (wr == 0) PG8_BAR; }
        if constexpr (!Epi::AFTER_DRAIN) { E(acc, cur, wr, wc, fr, fq); S.done(cur); }
        if (!has_next) break;
#pragma unroll
        for (int a = 0; a < 2; ++a)
#pragma unroll
            for (int b = 0; b < 2; ++b)
#pragma unroll
                for (int m = 0; m < 4; ++m)
#pragma unroll
                    for (int n = 0; n < 2; ++n) acc[a][b][m][n] = (f32x4){0.f, 0.f, 0.f, 0.f};
        cur = nxt; cA = nA; cB = nB; ++ui;
        if constexpr (ALIGN_EPI) { if (wr == 1) PG8_BAR; }
    }
    PG8_WAIT_V(0);
    if constexpr (!ALIGN_EPI) { if (wr == 0) PG8_BAR; }
    PG8_BAR;
    if constexpr (Epi::AFTER_DRAIN) { E.fused(acc, cur, wr, wc, fr, fq, lds, wid, lane); S.done(cur); }
#undef PG8_SA
#undef PG8_SB
#undef PG8_STAGE
#undef PG8_LDA
#undef PG8_LDB
#undef PG8_MMA
#undef PG8_WAIT_V
#undef PG8_WAIT_L
#undef PG8_BAR
#undef PG8_SCHED
}
}
namespace pg8 {
typedef __bf16 bf16x2n __attribute__((ext_vector_type(2)));
typedef float f32x2n __attribute__((ext_vector_type(2)));
__device__ __forceinline__ unsigned cvt_pk_bf16(float lo, float hi) { const f32x2n v = {lo, hi}; const bf16x2n b = __builtin_convertvector(v, bf16x2n); return __builtin_bit_cast(unsigned, b); }
__device__ __forceinline__ float fsig(float x) { return __builtin_amdgcn_rcpf(1.0f + __builtin_amdgcn_exp2f(-1.44269504089f * x)); }
__device__ __forceinline__ float fsilu(float x) { return x * fsig(x); }
__device__ __forceinline__ float fgelu(float y) { return y * fsig(1.59576912161f * (y + 0.044715f * y * y * y)); }
__device__ __forceinline__ f32x4 vsig(f32x4 v) { return (f32x4){fsig(v[0]), fsig(v[1]), fsig(v[2]), fsig(v[3])}; }
__device__ __forceinline__ f32x4 vsilu(f32x4 v) { return (f32x4){fsilu(v[0]), fsilu(v[1]), fsilu(v[2]), fsilu(v[3])}; }
__device__ __forceinline__ f32x4 vgelu(f32x4 v) { return (f32x4){fgelu(v[0]), fgelu(v[1]), fgelu(v[2]), fgelu(v[3])}; }
__device__ __forceinline__ u32x4 pack8(f32x4 a, f32x4 b) { u32x4 w; w.x = cvt_pk_bf16(a[0], a[1]); w.y = cvt_pk_bf16(a[2], a[3]); w.z = cvt_pk_bf16(b[0], b[1]); w.w = cvt_pk_bf16(b[2], b[3]); return w; }
__device__ __forceinline__ void unpack8(u32x4 w, f32x4& a, f32x4& b) {
    a[0] = __uint_as_float(w.x << 16); a[1] = __uint_as_float(w.x & 0xffff0000u); a[2] = __uint_as_float(w.y << 16); a[3] = __uint_as_float(w.y & 0xffff0000u);
    b[0] = __uint_as_float(w.z << 16); b[1] = __uint_as_float(w.z & 0xffff0000u); b[2] = __uint_as_float(w.w << 16); b[3] = __uint_as_float(w.w & 0xffff0000u); }

struct EpiP1 {
    static constexpr bool PERM = true, AFTER_DRAIN = false;
    bf16_t *ACAT, *SZA, *CV, *BZ, *SGA, *SGB; int pn_off;
    __device__ __forceinline__ void operator()(const f32x4 (&acc)[2][2][4][2], const Unit& u, int wr, int wc, int fr, int fq) const {
        const int pn = u.pn + pn_off, row0 = u.pm * BM + wr * 64 + fr, cl = wc * 32 + 8 * fq;
        if (pn < 4) {
#pragma unroll
            for (int ai = 0; ai < 2; ++ai)
#pragma unroll
                for (int m = 0; m < 4; ++m) { const int r = row0 + ai * HALF + m * 16;
#pragma unroll
                    for (int bj = 0; bj < 2; ++bj) { const int col = pn * 256 + bj * HALF + cl, g = col >> 4, h0 = col & 15;
                        *(u32x4*)(ACAT + ((size_t)(g * 1024 + (r >> 5)) * 768 + (r & 31) * 16 + h0)) = pack8(acc[ai][bj][m][0], acc[ai][bj][m][1]); } }
        } else if (pn < 12) {
#pragma unroll
            for (int ai = 0; ai < 2; ++ai)
#pragma unroll
                for (int m = 0; m < 4; ++m) { bf16_t* rowp = CV + (size_t)(row0 + ai * HALF + m * 16) * 1024 + (pn - 4) * 128 + cl;
                    *(u32x4*)rowp = pack8(acc[ai][0][m][0] * acc[ai][1][m][0], acc[ai][0][m][1] * acc[ai][1][m][1]); }
        } else if (pn < 20) {
#pragma unroll
            for (int ai = 0; ai < 2; ++ai)
#pragma unroll
                for (int m = 0; m < 4; ++m) { bf16_t* rowp = BZ + (size_t)(row0 + ai * HALF + m * 16) * 1024 + (pn - 12) * 128 + cl;
                    *(u32x4*)rowp = pack8(acc[ai][0][m][0] * vsilu(acc[ai][1][m][0]), acc[ai][0][m][1] * vsilu(acc[ai][1][m][1])); }
        } else if (pn < 24) {
#pragma unroll
            for (int ai = 0; ai < 2; ++ai)
#pragma unroll
                for (int m = 0; m < 4; ++m) { bf16_t* rowp = SZA + (size_t)(row0 + ai * HALF + m * 16) * 1024 + (pn - 20) * 256 + cl;
#pragma unroll
                    for (int bj = 0; bj < 2; ++bj) *(u32x4*)(rowp + bj * HALF) = pack8(vsilu(acc[ai][bj][m][0]), vsilu(acc[ai][bj][m][1])); }
        } else {
            bf16_t* base = pn < 28 ? SGA + (pn - 24) * 256 : SGB + (pn - 28) * 256;
#pragma unroll
            for (int ai = 0; ai < 2; ++ai)
#pragma unroll
                for (int m = 0; m < 4; ++m) { bf16_t* rowp = base + (size_t)(row0 + ai * HALF + m * 16) * 1024 + cl;
#pragma unroll
                    for (int bj = 0; bj < 2; ++bj) *(u32x4*)(rowp + bj * HALF) = pack8(vsig(acc[ai][bj][m][0]), vsig(acc[ai][bj][m][1])); }
        }
    }
};
struct EpiE {
    static constexpr bool PERM = true, AFTER_DRAIN = false;
    bf16_t* E;
    __device__ __forceinline__ void operator()(const f32x4 (&acc)[2][2][4][2], const Unit& u, int wr, int wc, int fr, int fq) const {
        const int row0 = u.pm * BM + wr * 64 + fr, cl = wc * 32 + 8 * fq;
#pragma unroll
        for (int ai = 0; ai < 2; ++ai)
#pragma unroll
            for (int m = 0; m < 4; ++m) { bf16_t* rowp = E + (size_t)(row0 + ai * HALF + m * 16) * 256 + cl;
#pragma unroll
                for (int bj = 0; bj < 2; ++bj) *(u32x4*)(rowp + bj * HALF) = pack8(acc[ai][bj][m][0], acc[ai][bj][m][1]); }
    }
};
struct EpiY {
    static constexpr bool PERM = true, AFTER_DRAIN = false;
    bf16_t* GY;
    __device__ __forceinline__ void operator()(const f32x4 (&acc)[2][2][4][2], const Unit& u, int wr, int wc, int fr, int fq) const {
        const int g = u.pm >> 2, n0 = (u.pm & 3) * 256 + wr * 64 + fr, oc0 = (u.pn & 1) * 256 + wc * 32 + 8 * fq;
#pragma unroll
        for (int ai = 0; ai < 2; ++ai)
#pragma unroll
            for (int m = 0; m < 4; ++m) { const int n = n0 + ai * HALF + m * 16, b = n >> 7, c = n & 127;
#pragma unroll
                for (int bj = 0; bj < 2; ++bj) { const int oc = oc0 + bj * HALF, i = oc >> 4, h0 = oc & 15; const size_t tok = (size_t)b * 4096 + c * 32 + i;
                    *(u32x4*)(GY + tok * 1024 + g * 16 + h0) = pack8(vgelu(acc[ai][bj][m][0]), vgelu(acc[ai][bj][m][1])); } }
    }
};
struct EpiGLU {
    static constexpr bool PERM = true, AFTER_DRAIN = false;
    const bf16_t *GY, *SZA; bf16_t* YA;
    __device__ __forceinline__ void operator()(const f32x4 (&acc)[2][2][4][2], const Unit& u, int wr, int wc, int fr, int fq) const {
        const int row0 = u.pm * BM + wr * 64 + fr, col0 = u.pn * BM + wc * 32 + 8 * fq;
#pragma unroll
        for (int ai = 0; ai < 2; ++ai)
#pragma unroll
            for (int m = 0; m < 4; ++m) { const size_t off = (size_t)(row0 + ai * HALF + m * 16) * 1024 + col0;
#pragma unroll
                for (int bj = 0; bj < 2; ++bj) { f32x4 g0, g1, z0, z1; unpack8(*(const u32x4*)(GY + off + bj * HALF), g0, g1); unpack8(*(const u32x4*)(SZA + off + bj * HALF), z0, z1);
                    *(u32x4*)(YA + off + bj * HALF) = pack8(g0 * vsig(acc[ai][bj][m][0]) * z0, g1 * vsig(acc[ai][bj][m][1]) * z1); } }
    }
};
template <bool ADD> struct EpiGate {
    static constexpr bool PERM = true, AFTER_DRAIN = false;
    const bf16_t *SG, *PREV; bf16_t* O;
    __device__ __forceinline__ void operator()(const f32x4 (&acc)[2][2][4][2], const Unit& u, int wr, int wc, int fr, int fq) const {
        const int row0 = u.pm * BM + wr * 64 + fr, col0 = u.pn * BM + wc * 32 + 8 * fq;
#pragma unroll
        for (int ai = 0; ai < 2; ++ai)
#pragma unroll
            for (int m = 0; m < 4; ++m) { const size_t off = (size_t)(row0 + ai * HALF + m * 16) * 1024 + col0;
#pragma unroll
                for (int bj = 0; bj < 2; ++bj) { f32x4 s0, s1; unpack8(*(const u32x4*)(SG + off + bj * HALF), s0, s1);
                    f32x4 v0 = s0 * acc[ai][bj][m][0], v1 = s1 * acc[ai][bj][m][1];
                    if (ADD) { f32x4 p0, p1; unpack8(*(const u32x4*)(PREV + off + bj * HALF), p0, p1); v0 += p0; v1 += p1; }
                    *(u32x4*)(O + off + bj * HALF) = pack8(v0, v1); } }
    }
};
struct EpiOut {
    static constexpr bool PERM = false, AFTER_DRAIN = false;
    const float* X; float* O; float* SSQ;
    __device__ __forceinline__ void operator()(const f32x4 (&acc)[2][2][4][2], const Unit& u, int wr, int wc, int fr, int fq) const {
        const int row0 = u.pm * BM + wr * 64 + fr, col0 = u.pn * BM + wc * 32 + 4 * fq;
#pragma unroll
        for (int ai = 0; ai < 2; ++ai)
#pragma unroll
            for (int m = 0; m < 4; ++m) { const int r = row0 + ai * HALF + m * 16; const size_t off = (size_t)r * 1024 + col0; float s = 0.f;
#pragma unroll
                for (int bj = 0; bj < 2; ++bj)
#pragma unroll
                    for (int n = 0; n < 2; ++n) { const f32x4 h = *(const f32x4*)(X + off + bj * HALF + n * 16) + acc[ai][bj][m][n];
                        *(f32x4*)(O + off + bj * HALF + n * 16) = h; s += (h[0] * h[0] + h[1] * h[1]) + (h[2] * h[2] + h[3] * h[3]); }
                s += __shfl_xor(s, 16); s += __shfl_xor(s, 32);
                if (fq == 0) SSQ[(size_t)r * 16 + u.pn * 4 + wc] = s; }
    }
};
struct GroupOrder {
    int per_g, nj, total, G, c;
    __device__ __forceinline__ bool next(int i, Unit& u) const { const int L = i * G + c; if (L >= total) return false; const int g = L / per_g, rem = L - g * per_g, r = rem / nj, j = rem - r * nj; u.pm = g * 4 + r; u.pn = g * nj + j; return true; }
    __device__ __forceinline__ void a_ready(const Unit&) const {}
    __device__ __forceinline__ void done(const Unit&) const {}
};
}

namespace pg8 {
template <class Epi, class Sched>
__device__ __forceinline__ void gemm_phase_ref(const Gemm g, const Sched& S, const Epi& E) {
    const int tid = threadIdx.x, wid = __builtin_amdgcn_readfirstlane(tid >> 6), lane = tid & 63, wr = wid >> 2, wc = wid & 3, fr = lane & 15, fq = lane >> 4;
    Unit u;
    for (int ui = 0; S.next(ui, u); ++ui) {
        f32x4 acc[2][2][4][2];
#pragma unroll
        for (int a = 0; a < 2; ++a)
#pragma unroll
            for (int b = 0; b < 2; ++b)
#pragma unroll
                for (int m = 0; m < 4; ++m)
#pragma unroll
                    for (int n = 0; n < 2; ++n) acc[a][b][m][n] = (f32x4){0.f, 0.f, 0.f, 0.f};
        const bf16_t* Ab = g.A + (size_t)u.pm * 256 * g.lda + (size_t)(wr * 64 + fr) * g.lda;
        const bf16_t* Bb = g.Bt + (size_t)u.pn * 256 * g.ldb + (size_t)(wc * 32) * g.ldb;
        for (int k = 0; k < g.K; k += 8) {
#pragma unroll
            for (int ai = 0; ai < 2; ++ai) {
                f32x4 a0[4], a1[4];
#pragma unroll
                for (int m = 0; m < 4; ++m) unpack8(*(const u32x4*)(Ab + (size_t)(ai * 128 + m * 16) * g.lda + k), a0[m], a1[m]);
#pragma unroll
                for (int bj = 0; bj < 2; ++bj)
#pragma unroll
                    for (int n = 0; n < 2; ++n)
#pragma unroll
                        for (int e = 0; e < 4; ++e) {
                            const int col = bj * 128 + (Epi::PERM ? 8 * fq + 4 * n + e : 16 * n + 4 * fq + e);
                            f32x4 b0, b1; unpack8(*(const u32x4*)(Bb + (size_t)col * g.ldb + k), b0, b1);
#pragma unroll
                            for (int m = 0; m < 4; ++m) { const f32x4 p = a0[m] * b0 + a1[m] * b1; acc[ai][bj][m][n][e] += (p[0] + p[1]) + (p[2] + p[3]); }
                        }
                asm volatile("" ::: "memory");
            }
        }
        E(acc, u, wr, wc, fr, fq);
    }
}
}
#ifndef REFMASK
#define REFMASK 0x0
#endif
#define RUN_GEMM(PH, EPI, SCHED, g, S, Ep) do { if constexpr ((REFMASK >> (PH)) & 1) pg8::gemm_phase_ref<EPI, SCHED>(g, S, Ep); else pg8::gemm_phase<EPI, SCHED, true, true>(lds, g, S, Ep); } while (0)
constexpr int NWAVES = 8, NTHR = 512;
constexpr int M = 32768, D = 1024, SEQ = 4096, NIN = 8192, NG = 64, KA = 768;
constexpr float EPS = 1e-6f;
constexpr size_t MiB = 1u << 20;
constexpr size_t WS_AT = 0, WS_SSQ = 1 * MiB, WS_WIN = 4 * MiB, WS_WGLU = 20 * MiB, WS_WA = 22 * MiB, WS_WB = 24 * MiB, WS_WOUT = 26 * MiB, WS_PT = 28 * MiB, WS_MQT = 44 * MiB;
constexpr size_t WS_XN = 96 * MiB  , WS_ACAT = 160 * MiB  , WS_E = 256 * MiB  ;
constexpr size_t WS_CV = 288 * MiB  , WS_BZ = 352 * MiB  , WS_YB = 416 * MiB  , WS_END = 480 * MiB;
constexpr int LDS_BYTES = 147456;
#define LAS __attribute__((address_space(3)))
typedef unsigned short bf16;
typedef unsigned v4u __attribute__((ext_vector_type(4)));
typedef float f32x4 __attribute__((ext_vector_type(4)));
#define LDS_WAIT() asm volatile("s_waitcnt lgkmcnt(0)" ::: "memory")
__device__ __forceinline__ unsigned pk2(float lo, float hi) { return pg8::cvt_pk_bf16(lo, hi); }
__device__ __forceinline__ float wave_sum(float v) {
#pragma unroll
    for (int o = 1; o < 64; o <<= 1) v += __shfl_xor(v, o);
    return v;
}
__device__ __forceinline__ int win_src(int j) {
    const int pn = j >> 8, jj = j & 255;
    if (pn < 4) return pn * 256 + jj;
    if (pn < 12) { const int q = pn - 4; return jj < 128 ? 2048 + q * 128 + jj : 4096 + q * 128 + (jj - 128); }
    if (pn < 20) { const int q = pn - 12; return jj < 128 ? 3072 + q * 128 + jj : 5120 + q * 128 + (jj - 128); }
    if (pn < 24) return 1024 + (pn - 20) * 256 + jj;
    if (pn < 28) return 6144 + (pn - 24) * 256 + jj;
    return 7168 + (pn - 28) * 256 + jj;
}
__device__ __forceinline__ void p0_transpose_item(const float* W, int ldw, int src_col0, bf16* WT, int K, int dst_row0, int k0, LAS float* scr, int lane) {
#pragma unroll 8
    for (int i = 0; i < 32; ++i) { const int kk = 2 * i + (lane >> 5); scr[kk * 33 + (lane & 31)] = W[(size_t)(k0 + kk) * ldw + src_col0 + (lane & 31)]; }
    LDS_WAIT(); asm volatile("" ::: "memory");
    const int c = lane & 7;
#pragma unroll
    for (int j = 0; j < 4; ++j) { const int n = (lane >> 3) + 8 * j; const LAS float* s = scr + (8 * c) * 33 + n;
        v4u o; o.x = pk2(s[0 * 33], s[1 * 33]); o.y = pk2(s[2 * 33], s[3 * 33]); o.z = pk2(s[4 * 33], s[5 * 33]); o.w = pk2(s[6 * 33], s[7 * 33]);
        *(v4u*)(WT + (size_t)(dst_row0 + n) * K + k0 + 8 * c) = o; }
    LDS_WAIT(); asm volatile("" ::: "memory");
}
struct Args { const float* in[18]; float* out; unsigned char* ws; int ph_lo, ph_hi; };

__device__ __forceinline__ void p0_ssm_setup(const Args& a, LAS unsigned char* lds, int g, int q, int tid) {
    const float *lam_re = a.in[3], *lam_im = a.in[4], *log_dt = a.in[5], *b_re = a.in[6], *b_im = a.in[7], *c_re = a.in[8], *c_im = a.in[9], *ssm_d = a.in[10];
    LAS float* Apow = (LAS float*)lds;
    LAS float* Bb = Apow + 8704;
    LAS float* Cc = Bb + 4096;
    LAS float* Kt = Cc + 4096;
    bf16* MQt = (bf16*)(a.ws + WS_MQT); bf16* Pt = (bf16*)(a.ws + WS_PT); float* ATt = (float*)(a.ws + WS_AT);
    if (tid < 128) {
        const int dir = tid >> 6, p = tid & 63, gi = dir * 64 + g;
        const float dt = expf(log_dt[gi]), lr = lam_re[gi * 64 + p], li = lam_im[gi * 64 + p];
        const float mag = expf(lr * dt), th = li * dt, k = rintf(th * 0.15915494309f);
        float r = fmaf(-k, 6.2831854820251465f, th); r = fmaf(-k, -1.7484555e-7f, r);
        const float Ar = mag * cosf(r), Ai = mag * sinf(r);
        float pr = 1.f, pi = 0.f; const int base = (dir * 64 + p) * 34;
        for (int d = 0; d <= 32; ++d) { Apow[(base + d) * 2] = pr; Apow[(base + d) * 2 + 1] = pi; const float nr_ = pr * Ar - pi * Ai, ni_ = pr * Ai + pi * Ar; pr = nr_; pi = ni_; }
        const float den = lr * lr + li * li, nr = Ar - 1.0f, ni = Ai, cr = (nr * lr + ni * li) / den, ci = (ni * lr - nr * li) / den;
        for (int h = 0; h < 16; ++h) { const float br = b_re[(gi * 64 + p) * 16 + h], bi = b_im[(gi * 64 + p) * 16 + h];
            Bb[((dir * 64 + p) * 16 + h) * 2] = cr * br - ci * bi; Bb[((dir * 64 + p) * 16 + h) * 2 + 1] = cr * bi + ci * br; }
    }
    for (int idx = tid; idx < 2048; idx += NTHR) { const int dir = idx >> 10, rem = idx & 1023; Cc[idx * 2] = c_re[(dir * 64 + g) * 1024 + rem]; Cc[idx * 2 + 1] = c_im[(dir * 64 + g) * 1024 + rem]; }
    __syncthreads();
    {
        const int hh = tid & 255, h = hh >> 4, hp = hh & 15, dir = tid >> 8;
        float acc[32];
#pragma unroll
        for (int d = 0; d < 32; ++d) acc[d] = 0.f;
        for (int p = 0; p < 64; ++p) {
            const float Cr = Cc[((dir * 16 + h) * 64 + p) * 2], Ci = Cc[((dir * 16 + h) * 64 + p) * 2 + 1], Br = Bb[((dir * 64 + p) * 16 + hp) * 2], Bi = Bb[((dir * 64 + p) * 16 + hp) * 2 + 1];
            const float Wr = Cr * Br - Ci * Bi, Wi = Cr * Bi + Ci * Br;
            const LAS float* ap = Apow + (dir * 64 + p) * 68;
#pragma unroll
            for (int d = 0; d < 32; ++d) acc[d] += Wr * ap[2 * d] - Wi * ap[2 * d + 1];
        }
#pragma unroll
        for (int d = 0; d < 32; ++d) Kt[((dir * 32 + d) * 16 + h) * 16 + hp] = acc[d];
    }
    __syncthreads();
    for (int idx = tid; idx < 128 * 96; idx += NTHR) {
        const int rowl = idx / 96, ch = idx - rowl * 96, i = 8 * q + (rowl >> 4), h = rowl & 15;
        float v[8];
        if (ch < 64) {
            const int j = ch >> 1, h0 = (ch & 1) * 8;
            if (j != i) { const LAS float* src = Kt + (((j < i ? (i - j) : 32 + (j - i)) * 16 + h) * 16 + h0);
#pragma unroll
                for (int k = 0; k < 8; ++k) v[k] = src[k];
            } else { const LAS float* s0 = Kt + (h * 16 + h0); const LAS float* s1 = Kt + ((32 * 16 + h) * 16 + h0); const float dv = ssm_d[g * 16 + h];
#pragma unroll
                for (int k = 0; k < 8; ++k) v[k] = s0[k] + s1[k] + ((h0 + k) == h ? dv : 0.f);
            }
        } else {
            const int sc0 = (ch - 64) * 8, dir = sc0 >> 7, p0 = (sc0 & 127) >> 1, e = dir ? 32 - i : i + 1;
#pragma unroll
            for (int k = 0; k < 4; ++k) { const int p = p0 + k; const float Ar = Apow[((dir * 64 + p) * 34 + e) * 2], Ai = Apow[((dir * 64 + p) * 34 + e) * 2 + 1];
                const float Cr = Cc[((dir * 16 + h) * 64 + p) * 2], Ci = Cc[((dir * 16 + h) * 64 + p) * 2 + 1];
                v[2 * k] = Cr * Ar - Ci * Ai; v[2 * k + 1] = -(Cr * Ai + Ci * Ar); }
        }
        v4u o; o.x = pk2(v[0], v[1]); o.y = pk2(v[2], v[3]); o.z = pk2(v[4], v[5]); o.w = pk2(v[6], v[7]);
        *(v4u*)(MQt + ((size_t)(g * 512 + i * 16 + h) * KA + ch * 8)) = o;
    }
    for (int idx = tid; idx < 64 * 64; idx += NTHR) {
        const int scl = idx >> 6, ch = idx & 63, sc = 64 * q + scl, dir = sc >> 7, p = (sc & 127) >> 1, ri = sc & 1, j = ch >> 1, h0 = (ch & 1) * 8, e = dir ? j : 31 - j;
        const float Ar = Apow[((dir * 64 + p) * 34 + e) * 2], Ai = Apow[((dir * 64 + p) * 34 + e) * 2 + 1];
        float v[8];
#pragma unroll
        for (int k = 0; k < 8; ++k) { const float Br = Bb[((dir * 64 + p) * 16 + h0 + k) * 2], Bi = Bb[((dir * 64 + p) * 16 + h0 + k) * 2 + 1]; v[k] = ri ? (Ar * Bi + Ai * Br) : (Ar * Br - Ai * Bi); }
        v4u o; o.x = pk2(v[0], v[1]); o.y = pk2(v[2], v[3]); o.z = pk2(v[4], v[5]); o.w = pk2(v[6], v[7]);
        *(v4u*)(Pt + ((size_t)(g * 256 + sc) * 512 + ch * 8)) = o;
    }
    if (q == 0 && tid < 128) { const int dir = tid >> 6, p = tid & 63; ATt[((g * 2 + dir) * 64 + p) * 2] = Apow[((dir * 64 + p) * 34 + 32) * 2]; ATt[((g * 2 + dir) * 64 + p) * 2 + 1] = Apow[((dir * 64 + p) * 34 + 32) * 2 + 1]; }
    __syncthreads();
}

__global__ void __launch_bounds__(NTHR, 2) s5conv_fwd(Args a) {
    extern __shared__ __attribute__((aligned(16))) unsigned char lds_raw[];
    LAS unsigned char* lds = (LAS unsigned char*)lds_raw;
    cg::grid_group grid = cg::this_grid();
    const int tid = threadIdx.x, lane = tid & 63, wave = __builtin_amdgcn_readfirstlane(tid >> 6);
    const int G = gridDim.x, bx = blockIdx.x;
    const int gw = bx * NWAVES + wave, NGW = G * NWAVES;
    unsigned char* ws = a.ws;
    bf16 *WinT = (bf16*)(ws + WS_WIN), *WgluT = (bf16*)(ws + WS_WGLU), *WaT = (bf16*)(ws + WS_WA), *WbT = (bf16*)(ws + WS_WB), *WoutT = (bf16*)(ws + WS_WOUT);
    bf16 *Pt = (bf16*)(ws + WS_PT), *MQt = (bf16*)(ws + WS_MQT), *XN = (bf16*)(ws + WS_XN), *YA = (bf16*)(ws + WS_XN), *MG = (bf16*)(ws + WS_XN), *ACAT = (bf16*)(ws + WS_ACAT), *E = (bf16*)(ws + WS_E);
    bf16 *SZA = (bf16*)(ws + WS_ACAT), *SGB = (bf16*)(ws + WS_ACAT + 64 * MiB), *CV = (bf16*)(ws + WS_CV), *GY = (bf16*)(ws + WS_CV), *OA = (bf16*)(ws + WS_CV), *BZ = (bf16*)(ws + WS_BZ), *SGA = (bf16*)(ws + WS_BZ), *YB = (bf16*)(ws + WS_YB);
    float* SSQ = (float*)(ws + WS_SSQ);
    const int lo = a.ph_lo, hi = a.ph_hi;
#define IN(k) (lo <= (k) && (k) < hi)
#define SEAM(k) do { if (IN(k) && IN((k) + 1)) grid.sync(); } while (0)

    if (IN(0)) {
        for (int u = bx; u < NG * 4; u += G) p0_ssm_setup(a, lds, u >> 2, u & 3, tid);
        LAS float* scr = (LAS float*)(lds + wave * 16384);
        for (int it = gw; it < 4096 + 4 * 512; it += NGW) {
            if (it < 4096) { const int kb = it >> 8, nb = it & 255; p0_transpose_item(a.in[2], NIN, win_src(nb * 32), WinT, D, nb * 32, kb * 64, scr, lane); }
            else { const int r = it - 4096, w = r >> 9, kb = (r & 511) >> 5, nb = r & 31;
                const float* W = w == 0 ? a.in[11] : w == 1 ? a.in[14] : w == 2 ? a.in[15] : a.in[16]; bf16* WT = w == 0 ? WgluT : w == 1 ? WaT : w == 2 ? WbT : WoutT;
                p0_transpose_item(W, D, nb * 32, WT, D, nb * 32, kb * 64, scr, lane); }
        }
        const float* ng = a.in[1];
        f32x4 gv[4];
#pragma unroll
        for (int j = 0; j < 4; ++j) gv[j] = *((const f32x4*)ng + lane + 64 * j);
        for (int m = gw; m < M; m += NGW) {
            const f32x4* xr = (const f32x4*)(a.in[0] + (size_t)m * D) + lane; f32x4 v[4]; float s = 0.f;
#pragma unroll
            for (int j = 0; j < 4; ++j) { v[j] = xr[64 * j]; s += (v[j].x * v[j].x + v[j].y * v[j].y) + (v[j].z * v[j].z + v[j].w * v[j].w); }
            const float rs = 1.0f / sqrtf(wave_sum(s) * (1.f / D) + EPS);
            unsigned long long* o8 = (unsigned long long*)(XN + (size_t)m * D) + lane;
#pragma unroll
            for (int j = 0; j < 4; ++j) { const f32x4 t = v[j] * rs * gv[j]; o8[64 * j] = (unsigned long long)pk2(t.x, t.y) | ((unsigned long long)pk2(t.z, t.w) << 32); }
        }
    }
    SEAM(0);
    if (IN(1)) {
        pg8::Gemm g{XN, WinT, D, D, D}; pg8::StaticOrder S; S.init(M, 20 * 256, G, bx);
        pg8::EpiP1 Ep{ACAT, SZA, CV, BZ, SGA, SGB, 0};
        RUN_GEMM(1, pg8::EpiP1, pg8::StaticOrder, g, S, Ep);
    }
    SEAM(1);
    if (IN(2)) {
        pg8::Gemm g{ACAT, Pt, KA, 512, 512}; pg8::GroupOrder S{4, 1, NG * 4, G, bx};
        pg8::EpiE Ep{E};
        RUN_GEMM(2, pg8::EpiE, pg8::GroupOrder, g, S, Ep);
    }
    SEAM(2);
    if (IN(3)) {
        const float* ATt = (const float*)(ws + WS_AT);
        if (wave < 4) for (int w = bx * 4 + wave; w < NG * 8 * 2; w += G * 4) {
            const int g = w >> 4, b = (w >> 1) & 7, dir = w & 1, p = lane;
            const float ar = ATt[((g * 2 + dir) * 64 + p) * 2], ai = ATt[((g * 2 + dir) * 64 + p) * 2 + 1];
            const size_t n0 = (size_t)g * 1024 + b * 128;
            const unsigned* __restrict__ Ep = (const unsigned*)(E + n0 * 256 + dir * 128) + p;
            unsigned* __restrict__ Sp = (unsigned*)(ACAT + n0 * KA + 512 + dir * 128) + p;
            float sr = 0.f, si = 0.f;
            Sp[dir ? (size_t)127 * 384 : 0] = 0u;
            for (int k0 = 0; k0 < 128; k0 += 16) {
                unsigned e[16];
#pragma unroll
                for (int i = 0; i < 16; ++i) { const int k = k0 + i, c = dir ? 127 - k : k; e[i] = (k < 127) ? Ep[(size_t)c * 128] : 0u; }
#pragma unroll
                for (int i = 0; i < 16; ++i) { const int k = k0 + i, c = dir ? 127 - k : k;
                    if (k < 127) { const float er = __uint_as_float(e[i] << 16), ei = __uint_as_float(e[i] & 0xffff0000u);
                        const float nr = ar * sr - ai * si + er, ni = ar * si + ai * sr + ei; sr = nr; si = ni; Sp[(size_t)(dir ? c - 1 : c + 1) * 384] = pk2(sr, si); } }
            }
        }
        {
            const int gt = bx * NTHR + tid, ch = gt & 127; const float *cw = a.in[12], *cb = a.in[13];
            f32x4 w0[2], w1[2], w2[2], bb[2];
#pragma unroll
            for (int k = 0; k < 2; ++k) { w0[k] = *(const f32x4*)(cw + ch * 8 + 4 * k); w1[k] = *(const f32x4*)(cw + D + ch * 8 + 4 * k); w2[k] = *(const f32x4*)(cw + 2 * D + ch * 8 + 4 * k); bb[k] = *(const f32x4*)(cb + ch * 8 + 4 * k); }
            for (int it = gt; it < M * 128; it += G * NTHR) {
                const int r = it >> 7, t = r & (SEQ - 1); const size_t off = (size_t)r * D + ch * 8;
                f32x4 c0a, c0b, c1a, c1b, c2a, c2b, za, zb;
                const v4u zero = (v4u){0u, 0u, 0u, 0u};
                pg8::unpack8(t > 0 ? *(const v4u*)(CV + off - D) : zero, c0a, c0b); pg8::unpack8(*(const v4u*)(CV + off), c1a, c1b); pg8::unpack8(t < SEQ - 1 ? *(const v4u*)(CV + off + D) : zero, c2a, c2b);
                pg8::unpack8(*(const v4u*)(BZ + off), za, zb);
                const f32x4 ya = za * (bb[0] + w0[0] * c0a + w1[0] * c1a + w2[0] * c2a), yb = zb * (bb[1] + w0[1] * c0b + w1[1] * c1b + w2[1] * c2b);
                *(v4u*)(YB + off) = pg8::pack8(ya, yb);
            }
        }
    }
    SEAM(3);
    if (IN(4)) {
        pg8::Gemm g{ACAT, MQt, KA, KA, KA}; pg8::GroupOrder S{8, 2, NG * 8, G, bx};
        pg8::EpiY Ep{GY};
        RUN_GEMM(4, pg8::EpiY, pg8::GroupOrder, g, S, Ep);
    }
    SEAM(4);
    if (IN(5)) {
        pg8::Gemm g{XN, WinT + (size_t)20 * 256 * D, D, D, D}; pg8::StaticOrder S; S.init(M, 12 * 256, G, bx);
        pg8::EpiP1 Ep{ACAT, SZA, CV, BZ, SGA, SGB, 20};
        RUN_GEMM(5, pg8::EpiP1, pg8::StaticOrder, g, S, Ep);
    }
    SEAM(5);
    if (IN(6)) {
        pg8::Gemm g{GY, WgluT, D, D, D}; pg8::StaticOrder S; S.init(M, D, G, bx);
        pg8::EpiGLU Ep{GY, SZA, YA};
        RUN_GEMM(6, pg8::EpiGLU, pg8::StaticOrder, g, S, Ep);
    }
    SEAM(6);
    if (IN(7)) {
        pg8::Gemm g{YA, WaT, D, D, D}; pg8::StaticOrder S; S.init(M, D, G, bx);
        pg8::EpiGate<false> Ep{SGA, nullptr, OA};
        RUN_GEMM(7, pg8::EpiGate<false>, pg8::StaticOrder, g, S, Ep);
    }
    SEAM(7);
    if (IN(8)) {
        pg8::Gemm g{YB, WbT, D, D, D}; pg8::StaticOrder S; S.init(M, D, G, bx);
        pg8::EpiGate<true> Ep{SGB, OA, MG};
        RUN_GEMM(8, pg8::EpiGate<true>, pg8::StaticOrder, g, S, Ep);
    }
    SEAM(8);
    if (IN(9)) {
        pg8::Gemm g{MG, WoutT, D, D, D}; pg8::StaticOrder S; S.init(M, D, G, bx);
        pg8::EpiOut Ep{a.in[0], a.out, SSQ};
        RUN_GEMM(9, pg8::EpiOut, pg8::StaticOrder, g, S, Ep);
    }
    SEAM(9);
    if (IN(10)) {
        const float* fg = a.in[17];
        f32x4 gv[4];
#pragma unroll
        for (int j = 0; j < 4; ++j) gv[j] = *((const f32x4*)fg + lane + 64 * j);
        for (int m = gw; m < M; m += NGW) {
            float s = SSQ[(size_t)m * 16 + (lane & 15)];
            s += __shfl_xor(s, 1); s += __shfl_xor(s, 2); s += __shfl_xor(s, 4); s += __shfl_xor(s, 8);
            const float rs = 1.0f / sqrtf(s * (1.f / D) + EPS);
            f32x4* hr = (f32x4*)(a.out + (size_t)m * D) + lane;
#pragma unroll
            for (int j = 0; j < 4; ++j) hr[64 * j] = hr[64 * j] * rs * gv[j];
        }
    }
#undef IN
#undef SEAM
}

#ifndef MK_PER_PHASE
#define MK_PER_PHASE 0
#endif
constexpr int N_PHASES = 11;
extern "C" void kernel_launch(void* const* d_in, const int* in_sizes, int n_in, void* d_out, int out_size, void* d_ws, size_t ws_size, hipStream_t stream) {
    static int grid = 0;
    if (grid == 0) {
        if (n_in != 18 || in_sizes[0] != M * D || out_size != M * D || ws_size < WS_END) { fprintf(stderr, "kernel_launch: unexpected shapes (n_in %d, in0 %d, out %d, ws %zu)\n", n_in, n_in > 0 ? in_sizes[0] : -1, out_size, ws_size); grid = -1; return; }
        int dev = 0, cus = 0, per_cu = 0;
        if (hipGetDevice(&dev) != hipSuccess || hipDeviceGetAttribute(&cus, hipDeviceAttributeMultiprocessorCount, dev) != hipSuccess) { grid = -1; return; }
        if (hipFuncSetAttribute((const void*)s5conv_fwd, hipFuncAttributeMaxDynamicSharedMemorySize, LDS_BYTES) != hipSuccess) { fprintf(stderr, "kernel_launch: hipFuncSetAttribute failed\n"); grid = -1; return; }
        if (hipOccupancyMaxActiveBlocksPerMultiprocessor(&per_cu, (const void*)s5conv_fwd, NTHR, LDS_BYTES) != hipSuccess || per_cu < 1) { fprintf(stderr, "kernel_launch: occupancy query says %d\n", per_cu); per_cu = 1; }
        (void)hipGetLastError();
        grid = cus * 1;
    }
    if (grid < 0) return;
    Args a{};
    for (int i = 0; i < 18; ++i) a.in[i] = (const float*)d_in[i];
    a.out = (float*)d_out; a.ws = (unsigned char*)d_ws;
#if MK_PER_PHASE
    for (int ph = 0; ph < N_PHASES; ++ph) { a.ph_lo = ph; a.ph_hi = ph + 1; hipLaunchKernelGGL(s5conv_fwd, dim3(grid), dim3(NTHR), LDS_BYTES, stream, a); }
#else
    a.ph_lo = 0; a.ph_hi = N_PHASES;
    void* args[] = {&a};
    hipError_t e = hipLaunchCooperativeKernel((const void*)s5conv_fwd, dim3(grid), dim3(NTHR), args, LDS_BYTES, stream);
    if (e != hipSuccess) fprintf(stderr, "kernel_launch: cooperative launch failed: %s (grid %d)\n", hipGetErrorString(e), grid);
#endif
}
```

```cpp
#include <hip/hip_runtime.h>
#include <hip/hip_cooperative_groups.h>
#include <cstdio>
#include <cstdint>
namespace cg = cooperative_groups;
namespace pg8 {
#define PG8_LAS __attribute__((address_space(3)))
typedef unsigned short bf16_t;
typedef short bf16x8 __attribute__((ext_vector_type(8)));
typedef float f32x4 __attribute__((ext_vector_type(4)));
typedef unsigned u32x4 __attribute__((ext_vector_type(4)));
constexpr int BM = 256, BK = 64, HALF = 128, HTB = HALF * BK * 2  , STAGE_BYTES = 8 * HTB, NXCD = 8, WGM = 8;

__host__ __device__ __forceinline__ int lds_byte(int r, int c) { const int st = (r >> 4) * 2 + (c >> 5), rr = r & 15, cc = c & 31, ob = rr * 64 + cc * 2; return st * 1024 + (ob ^ (((ob >> 9) & 1) << 5)); }
__host__ __device__ __forceinline__ void stage_rc(int b, int& R, int& C) { const int st = b / 1024, sb = b % 1024, swz = sb ^ (((sb >> 9) & 1) << 5); R = (st >> 1) * 16 + swz / 64; C = (st & 1) * 32 + (swz % 64) / 2; }
__host__ __device__ __forceinline__ int perm32(int rho) { const int n = rho >> 4, i = rho & 15; return 8 * (i >> 2) + 4 * n + (i & 3); }

struct Unit { int pm, pn; };
struct Gemm { const bf16_t* A; const bf16_t* Bt; int lda, ldb, K; };

struct StaticOrder {
    int nM, nN, nwg, G, c;
    __host__ __device__ void init(int M, int N, int G_, int c_) { nM = M / BM; nN = N / BM; nwg = nM * nN; G = G_; c = c_; }
    __host__ __device__ bool next(int i, Unit& u) const {
        const long L = (long)i * G + c; if (L >= nwg) return false;
        int wgid = (int)L; { const int q = nwg / NXCD, r = nwg % NXCD, xcd = wgid % NXCD, off = wgid / NXCD; wgid = (xcd < r ? xcd * (q + 1) : r * (q + 1) + (xcd - r) * q) + off; }
        const int nig = WGM * nN, gid = wgid / nig, fm = gid * WGM, gsz = (nM - fm) < WGM ? (nM - fm) : WGM;
        u.pm = fm + ((wgid % nig) % gsz); u.pn = (wgid % nig) / gsz; return true;
    }
    __device__ __forceinline__ void a_ready(const Unit&) const {}
    __device__ __forceinline__ void done(const Unit&) const {}
};

template <class Epi, class Sched, bool ALIGN_EPI = false, bool SP2 = false>
__device__ __forceinline__ void gemm_phase(PG8_LAS unsigned char* lds, const Gemm g, const Sched& S, const Epi& E) {
    const int tid = threadIdx.x, wid = __builtin_amdgcn_readfirstlane(tid >> 6), lane = tid & 63, wr = wid >> 2, wc = wid & 3, fr = lane & 15, fq = lane >> 4;
    const int K = g.K, nt = K / BK;
    unsigned voffA[2], voffB[2];
#pragma unroll
    for (int i = 0; i < 2; ++i) { int R, C; stage_rc(tid * 16 + i * 8192, R, C); const int Rb = Epi::PERM ? ((R & ~31) + perm32(R & 31)) : R;
        voffA[i] = (unsigned)(R * g.lda + C) * 2u; voffB[i] = (unsigned)(Rb * g.ldb + C) * 2u; }
    const size_t kstep = (size_t)(BK * 2);
    const size_t hstepA = (size_t)HALF * g.lda * 2, hstepB = (size_t)HALF * g.ldb * 2;
    const size_t tstepA = 2 * hstepA, tstepB = 2 * hstepB;
    const unsigned ldsw = (unsigned)wid * 1024u;
    const int aoff = lds_byte(wr * 64 + fr, fq * 8), boff = lds_byte(wc * 32 + fr, fq * 8);
#define PG8_SA(b, h) (((b) * 2 + (h)) * HTB)
#define PG8_SB(b, h) ((4 + (b) * 2 + (h)) * HTB)
#define PG8_STAGE(bufoff, gbase, voff) do { _Pragma("unroll") for (int _i = 0; _i < 2; ++_i) \
        __builtin_amdgcn_global_load_lds((const unsigned*)((const char*)(gbase) + (voff)[_i]), (PG8_LAS unsigned*)(lds + (bufoff) + ldsw + _i * 8192), 16, 0, 0); } while (0)
#define PG8_LDA(dst, b, h) do { _Pragma("unroll") for (int m = 0; m < 4; ++m) _Pragma("unroll") for (int k = 0; k < 2; ++k) dst[m][k] = *(const PG8_LAS bf16x8*)(lds + PG8_SA(b, h) + aoff + m * 2048 + k * 1024); } while (0)
#define PG8_LDB(dst, b, h) do { _Pragma("unroll") for (int n = 0; n < 2; ++n) _Pragma("unroll") for (int k = 0; k < 2; ++k) dst[n][k] = *(const PG8_LAS bf16x8*)(lds + PG8_SB(b, h) + boff + n * 2048 + k * 1024); } while (0)
#define PG8_MMA(ai, bj, At, Bt) do { __builtin_amdgcn_s_setprio(1); _Pragma("unroll") for (int m = 0; m < 4; ++m) _Pragma("unroll") for (int n = 0; n < 2; ++n) _Pragma("unroll") for (int k = 0; k < 2; ++k) \
        acc[ai][bj][m][n] = __builtin_amdgcn_mfma_f32_16x16x32_bf16(Bt[n][k], At[m][k], acc[ai][bj][m][n], 0, 0, 0); __builtin_amdgcn_s_setprio(0); } while (0)
#define PG8_WAIT_V(n) asm volatile("s_waitcnt vmcnt(" #n ")" ::: "memory")
#define PG8_WAIT_L(n) asm volatile("s_waitcnt lgkmcnt(" #n ")" ::: "memory")
#define PG8_BAR __builtin_amdgcn_s_barrier()
#define PG8_SCHED __builtin_amdgcn_sched_barrier(0)
    Unit cur, nxt; int ui = 0;
    if (!S.next(0, cur)) return;
    f32x4 acc[2][2][4][2];
#pragma unroll
    for (int a = 0; a < 2; ++a)
#pragma unroll
        for (int b = 0; b < 2; ++b)
#pragma unroll
            for (int m = 0; m < 4; ++m)
#pragma unroll
                for (int n = 0; n < 2; ++n) acc[a][b][m][n] = (f32x4){0.f, 0.f, 0.f, 0.f};
    bf16x8 At[4][2], B0[2][2], B1[2][2];
    const char* cA = (const char*)g.A + (size_t)cur.pm * tstepA; const char* cB = (const char*)g.Bt + (size_t)cur.pn * tstepB;
    S.a_ready(cur);
    if constexpr (SP2) {
        PG8_STAGE(PG8_SB(0, 0), cB, voffB); PG8_STAGE(PG8_SB(0, 1), cB + hstepB, voffB); PG8_STAGE(PG8_SA(0, 0), cA, voffA); PG8_STAGE(PG8_SA(0, 1), cA + hstepA, voffA);
        if (wr == 1) PG8_BAR;
        PG8_WAIT_V(2); PG8_BAR;
        PG8_STAGE(PG8_SB(1, 0), cB + kstep, voffB); PG8_STAGE(PG8_SA(1, 0), cA + kstep, voffA); PG8_STAGE(PG8_SB(1, 1), cB + hstepB + kstep, voffB);
        PG8_WAIT_V(6); PG8_BAR;
    } else {
        PG8_STAGE(PG8_SB(0, 0), cB, voffB); PG8_STAGE(PG8_SA(0, 0), cA, voffA); PG8_STAGE(PG8_SB(0, 1), cB + hstepB, voffB); PG8_STAGE(PG8_SA(0, 1), cA + hstepA, voffA);
        if (wr == 1) PG8_BAR;
        PG8_WAIT_V(4); PG8_BAR;
        PG8_STAGE(PG8_SB(1, 0), cB + kstep, voffB); PG8_STAGE(PG8_SA(1, 0), cA + kstep, voffA); PG8_STAGE(PG8_SB(1, 1), cB + hstepB + kstep, voffB);
        PG8_WAIT_V(6); PG8_BAR;
    }
    for (;;) {
        const bool has_next = S.next(ui + 1, nxt);
        const char* nA = has_next ? (const char*)g.A + (size_t)nxt.pm * tstepA : cA; const char* nB = has_next ? (const char*)g.Bt + (size_t)nxt.pn * tstepB : cB;
        for (int t = 0; t < nt; t += 2) {
            const bool last = (t == nt - 2);
            const char* a1 = cA + (size_t)(t + 1) * kstep;
            const char* a2 = last ? nA : cA + (size_t)(t + 2) * kstep; const char* b2 = last ? nB : cB + (size_t)(t + 2) * kstep;
            const char* a3 = a2 + kstep; const char* b3 = b2 + kstep;
            if (last && has_next) S.a_ready(nxt);
            if constexpr (SP2) {
            PG8_LDB(B0, 0, 0); PG8_LDB(B1, 0, 1); PG8_SCHED; PG8_LDA(At, 0, 0); PG8_STAGE(PG8_SA(1, 1), a1 + hstepA, voffA);
            PG8_WAIT_V(8); PG8_WAIT_L(0); PG8_BAR; PG8_MMA(0, 0, At, B0); PG8_MMA(0, 1, At, B1); PG8_BAR; PG8_SCHED;
            PG8_LDA(At, 0, 1); PG8_STAGE(PG8_SB(0, 0), b2, voffB); PG8_STAGE(PG8_SB(0, 1), b2 + hstepB, voffB); PG8_STAGE(PG8_SA(0, 0), a2, voffA);
            PG8_WAIT_V(8); PG8_WAIT_L(0); PG8_BAR; PG8_MMA(1, 0, At, B0); PG8_MMA(1, 1, At, B1); PG8_BAR; PG8_SCHED;
            PG8_LDB(B0, 1, 0); PG8_LDB(B1, 1, 1); PG8_SCHED; PG8_LDA(At, 1, 0); PG8_STAGE(PG8_SA(0, 1), a2 + hstepA, voffA);
            PG8_WAIT_V(8); PG8_WAIT_L(0); PG8_BAR; PG8_MMA(0, 0, At, B0); PG8_MMA(0, 1, At, B1); PG8_BAR; PG8_SCHED;
            PG8_LDA(At, 1, 1); PG8_STAGE(PG8_SB(1, 0), b3, voffB); PG8_STAGE(PG8_SB(1, 1), b3 + hstepB, voffB); PG8_STAGE(PG8_SA(1, 0), a3, voffA);
            PG8_WAIT_V(8); PG8_WAIT_L(0); PG8_BAR; PG8_MMA(1, 0, At, B0); PG8_MMA(1, 1, At, B1); PG8_BAR; PG8_SCHED;
            } else {
            PG8_LDB(B0, 0, 0); PG8_SCHED; PG8_LDA(At, 0, 0); PG8_STAGE(PG8_SA(1, 1), a1 + hstepA, voffA);
            PG8_WAIT_L(8); PG8_BAR; PG8_WAIT_L(0); PG8_MMA(0, 0, At, B0); PG8_BAR; PG8_SCHED;
            PG8_LDB(B1, 0, 1); PG8_STAGE(PG8_SB(0, 0), b2, voffB);
            PG8_BAR; PG8_WAIT_L(0); PG8_MMA(0, 1, At, B1); PG8_BAR;
            PG8_LDA(At, 0, 1); PG8_STAGE(PG8_SA(0, 0), a2, voffA);
            PG8_BAR; PG8_WAIT_L(0); PG8_MMA(1, 0, At, B0); PG8_BAR; PG8_SCHED;
            PG8_STAGE(PG8_SB(0, 1), b2 + hstepB, voffB);
            PG8_WAIT_V(6); PG8_BAR; PG8_MMA(1, 1, At, B1); PG8_BAR;
            PG8_LDB(B0, 1, 0); PG8_SCHED; PG8_LDA(At, 1, 0); PG8_STAGE(PG8_SA(0, 1), a2 + hstepA, voffA);
            PG8_WAIT_L(8); PG8_BAR; PG8_WAIT_L(0); PG8_MMA(0, 0, At, B0); PG8_BAR; PG8_SCHED;
            PG8_LDB(B1, 1, 1); PG8_STAGE(PG8_SB(1, 0), b3, voffB);
            PG8_BAR; PG8_WAIT_L(0); PG8_MMA(0, 1, At, B1); PG8_BAR;
            PG8_LDA(At, 1, 1); PG8_STAGE(PG8_SA(1, 0), a3, voffA);
            PG8_BAR; PG8_WAIT_L(0); PG8_MMA(1, 0, At, B0); PG8_BAR; PG8_SCHED;
            PG8_STAGE(PG8_SB(1, 1), b3 + hstepB, voffB);
            PG8_WAIT_V(6); PG8_BAR; PG8_MMA(1, 1, At, B1); PG8_BAR;
            }
        }
        if constexpr (ALIGN_EPI) { if (wr == 0) PG8_BAR; }
        if constexpr (!Epi::AFTER_DRAIN) { E(acc, cur, wr, wc, fr, fq); S.done(cur); }
        if (!has_next) break;
#pragma unroll
        for (int a = 0; a < 2; ++a)
#pragma unroll
            for (int b = 0; b < 2; ++b)
#pragma unroll
                for (int m = 0; m < 4; ++m)
#pragma unroll
                    for (int n = 0; n < 2; ++n) acc[a][b][m][n] = (f32x4){0.f, 0.f, 0.f, 0.f};
        cur = nxt; cA = nA; cB = nB; ++ui;
        if constexpr (ALIGN_EPI) { if (wr == 1) PG8_BAR; }
    }
    PG8_WAIT_V(0);
    if constexpr (!ALIGN_EPI) { if (wr == 0) PG8_BAR; }
    PG8_BAR;
    if constexpr (Epi::AFTER_DRAIN) { E.fused(acc, cur, wr, wc, fr, fq, lds, wid, lane); S.done(cur); }
#undef PG8_SA
#undef PG8_SB
#undef PG8_STAGE
#undef PG8_LDA
#undef PG8_LDB
#undef PG8_MMA
#undef PG8_WAIT_V
#undef PG8_WAIT_L
#undef PG8_BAR
#undef PG8_SCHED
}
}
namespace pg8 {
typedef __bf16 bf16x2n __attribute__((ext_vector_type(2)));
typedef float f32x2n __attribute__((ext_vector_type(2)));
__device__ __forceinline__ unsigned cvt_pk_bf16(float lo, float hi) { const f32x2n v = {lo, hi}; const bf16x2n b = __builtin_convertvector(v, bf16x2n); return __builtin_bit_cast(unsigned, b); }
__device__ __forceinline__ float fsig(float x) { return __builtin_amdgcn_rcpf(1.0f + __builtin_amdgcn_exp2f(-1.44269504089f * x)); }
__device__ __forceinline__ float fsilu(float x) { return x * fsig(x); }
__device__ __forceinline__ float fgelu(float y) { return y * fsig(1.59576912161f * (y + 0.044715f * y * y * y)); }
__device__ __forceinline__ f32x4 vsig(f32x4 v) { return (f32x4){fsig(v[0]), fsig(v[1]), fsig(v[2]), fsig(v[3])}; }
__device__ __forceinline__ f32x4 vsilu(f32x4 v) { return (f32x4){fsilu(v[0]), fsilu(v[1]), fsilu(v[2]), fsilu(v[3])}; }
__device__ __forceinline__ f32x4 vgelu(f32x4 v) { return (f32x4){fgelu(v[0]), fgelu(v[1]), fgelu(v[2]), fgelu(v[3])}; }
__device__ __forceinline__ u32x4 pack8(f32x4 a, f32x4 b) { u32x4 w; w.x = cvt_pk_bf16(a[0], a[1]); w.y = cvt_pk_bf16(a[2], a[3]); w.z = cvt_pk_bf16(b[0], b[1]); w.w = cvt_pk_bf16(b[2], b[3]); return w; }
__device__ __forceinline__ void unpack8(u32x4 w, f32x4& a, f32x4& b) {
    a[0] = __uint_as_float(w.x << 16); a[1] = __uint_as_float(w.x & 0xffff0000u); a[2] = __uint_as_float(w.y << 16); a[3] = __uint_as_float(w.y & 0xffff0000u);
    b[0] = __uint_as_float(w.z << 16); b[1] = __uint_as_float(w.z & 0xffff0000u); b[2] = __uint_as_float(w.w << 16); b[3] = __uint_as_float(w.w & 0xffff0000u); }

struct EpiP1 {
    static constexpr bool PERM = true, AFTER_DRAIN = false;
    bf16_t *ACAT, *SZA, *CV, *BZ, *SGA, *SGB; int pn_off;
    __device__ __forceinline__ void operator()(const f32x4 (&acc)[2][2][4][2], const Unit& u, int wr, int wc, int fr, int fq) const {
        const int pn = u.pn + pn_off, row0 = u.pm * BM + wr * 64 + fr, cl = wc * 32 + 8 * fq;
        if (pn < 4) {
#pragma unroll
            for (int ai = 0; ai < 2; ++ai)
#pragma unroll
                for (int m = 0; m < 4; ++m) { const int r = row0 + ai * HALF + m * 16;
#pragma unroll
                    for (int bj = 0; bj < 2; ++bj) { const int col = pn * 256 + bj * HALF + cl, g = col >> 4, h0 = col & 15;
                        *(u32x4*)(ACAT + ((size_t)(g * 1024 + (r >> 5)) * 768 + (r & 31) * 16 + h0)) = pack8(acc[ai][bj][m][0], acc[ai][bj][m][1]); } }
        } else if (pn < 12) {
#pragma unroll
            for (int ai = 0; ai < 2; ++ai)
#pragma unroll
                for (int m = 0; m < 4; ++m) { bf16_t* rowp = CV + (size_t)(row0 + ai * HALF + m * 16) * 1024 + (pn - 4) * 128 + cl;
                    *(u32x4*)rowp = pack8(acc[ai][0][m][0] * acc[ai][1][m][0], acc[ai][0][m][1] * acc[ai][1][m][1]); }
        } else if (pn < 20) {
#pragma unroll
            for (int ai = 0; ai < 2; ++ai)
#pragma unroll
                for (int m = 0; m < 4; ++m) { bf16_t* rowp = BZ + (size_t)(row0 + ai * HALF + m * 16) * 1024 + (pn - 12) * 128 + cl;
                    *(u32x4*)rowp = pack8(acc[ai][0][m][0] * vsilu(acc[ai][1][m][0]), acc[ai][0][m][1] * vsilu(acc[ai][1][m][1])); }
        } else if (pn < 24) {
#pragma unroll
            for (int ai = 0; ai < 2; ++ai)
#pragma unroll
                for (int m = 0; m < 4; ++m) { bf16_t* rowp = SZA + (size_t)(row0 + ai * HALF + m * 16) * 1024 + (pn - 20) * 256 + cl;
#pragma unroll
                    for (int bj = 0; bj < 2; ++bj) *(u32x4*)(rowp + bj * HALF) = pack8(vsilu(acc[ai][bj][m][0]), vsilu(acc[ai][bj][m][1])); }
        } else {
            bf16_t* base = pn < 28 ? SGA + (pn - 24) * 256 : SGB + (pn - 28) * 256;
#pragma unroll
            for (int ai = 0; ai < 2; ++ai)
#pragma unroll
                for (int m = 0; m < 4; ++m) { bf16_t* rowp = base + (size_t)(row0 + ai * HALF + m * 16) * 1024 + cl;
#pragma unroll
                    for (int bj = 0; bj < 2; ++bj) *(u32x4*)(rowp + bj * HALF) = pack8(vsig(acc[ai][bj][m][0]), vsig(acc[ai][bj][m][1])); }
        }
    }
};
struct EpiE {
    static constexpr bool PERM = true, AFTER_DRAIN = false;
    bf16_t* E;
    __device__ __forceinline__ void operator()(const f32x4 (&acc)[2][2][4][2], const Unit& u, int wr, int wc, int fr, int fq) const {
        const int row0 = u.pm * BM + wr * 64 + fr, cl = wc * 32 + 8 * fq;
#pragma unroll
        for (int ai = 0; ai < 2; ++ai)
#pragma unroll
            for (int m = 0; m < 4; ++m) { bf16_t* rowp = E + (size_t)(row0 + ai * HALF + m * 16) * 256 + cl;
#pragma unroll
                for (int bj = 0; bj < 2; ++bj) *(u32x4*)(rowp + bj * HALF) = pack8(acc[ai][bj][m][0], acc[ai][bj][m][1]); }
    }
};
struct EpiY {
    static constexpr bool PERM = true, AFTER_DRAIN = false;
    bf16_t* GY;
    __device__ __forceinline__ void operator()(const f32x4 (&acc)[2][2][4][2], const Unit& u, int wr, int wc, int fr, int fq) const {
        const int g = u.pm >> 2, n0 = (u.pm & 3) * 256 + wr * 64 + fr, oc0 = (u.pn & 1) * 256 + wc * 32 + 8 * fq;
#pragma unroll
        for (int ai = 0; ai < 2; ++ai)
#pragma unroll
            for (int m = 0; m < 4; ++m) { const int n = n0 + ai * HALF + m * 16, b = n >> 7, c = n & 127;
#pragma unroll
                for (int bj = 0; bj < 2; ++bj) { const int oc = oc0 + bj * HALF, i = oc >> 4, h0 = oc & 15; const size_t tok = (size_t)b * 4096 + c * 32 + i;
                    *(u32x4*)(GY + tok * 1024 + g * 16 + h0) = pack8(vgelu(acc[ai][bj][m][0]), vgelu(acc[ai][bj][m][1])); } }
    }
};
struct EpiGLU {
    static constexpr bool PERM = true, AFTER_DRAIN = false;
    const bf16_t *GY, *SZA; bf16_t* YA;
    __device__ __forceinline__ void operator()(const f32x4 (&acc)[2][2][4][2], const Unit& u, int wr, int wc, int fr, int fq) const {
        const int row0 = u.pm * BM + wr * 64 + fr, col0 = u.pn * BM + wc * 32 + 8 * fq;
#pragma unroll
        for (int ai = 0; ai < 2; ++ai)
#pragma unroll
            for (int m = 0; m < 4; ++m) { const size_t off = (size_t)(row0 + ai * HALF + m * 16) * 1024 + col0;
#pragma unroll
                for (int bj = 0; bj < 2; ++bj) { f32x4 g0, g1, z0, z1; unpack8(*(const u32x4*)(GY + off + bj * HALF), g0, g1); unpack8(*(const u32x4*)(SZA + off + bj * HALF), z0, z1);
                    *(u32x4*)(YA + off + bj * HALF) = pack8(g0 * vsig(acc[ai][bj][m][0]) * z0, g1 * vsig(acc[ai][bj][m][1]) * z1); } }
    }
};
template <bool ADD> struct EpiGate {
    static constexpr bool PERM = true, AFTER_DRAIN = false;
    const bf16_t *SG, *PREV; bf16_t* O;
    __device__ __forceinline__ void operator()(const f32x4 (&acc)[2][2][4][2], const Unit& u, int wr, int wc, int fr, int fq) const {
        const int row0 = u.pm * BM + wr * 64 + fr, col0 = u.pn * BM + wc * 32 + 8 * fq;
#pragma unroll
        for (int ai = 0; ai < 2; ++ai)
#pragma unroll
            for (int m = 0; m < 4; ++m) { const size_t off = (size_t)(row0 + ai * HALF + m * 16) * 1024 + col0;
#pragma unroll
                for (int bj = 0; bj < 2; ++bj) { f32x4 s0, s1; unpack8(*(const u32x4*)(SG + off + bj * HALF), s0, s1);
                    f32x4 v0 = s0 * acc[ai][bj][m][0], v1 = s1 * acc[ai][bj][m][1];
                    if (ADD) { f32x4 p0, p1; unpack8(*(const u32x4*)(PREV + off + bj * HALF), p0, p1); v0 += p0; v1 += p1; }
                    *(u32x4*)(O + off + bj * HALF) = pack8(v0, v1); } }
    }
};
struct EpiOut {
    static constexpr bool PERM = false, AFTER_DRAIN = false;
    const float* X; float* O; float* SSQ;
    __device__ __forceinline__ void operator()(const f32x4 (&acc)[2][2][4][2], const Unit& u, int wr, int wc, int fr, int fq) const {
        const int row0 = u.pm * BM + wr * 64 + fr, col0 = u.pn * BM + wc * 32 + 4 * fq;
#pragma unroll
        for (int ai = 0; ai < 2; ++ai)
#pragma unroll
            for (int m = 0; m < 4; ++m) { const int r = row0 + ai * HALF + m * 16; const size_t off = (size_t)r * 1024 + col0; float s = 0.f;
#pragma unroll
                for (int bj = 0; bj < 2; ++bj)
#pragma unroll
                    for (int n = 0; n < 2; ++n) { const f32x4 h = *(const f32x4*)(X + off + bj * HALF + n * 16) + acc[ai][bj][m][n];
                        *(f32x4*)(O + off + bj * HALF + n * 16) = h; s += (h[0] * h[0] + h[1] * h[1]) + (h[2] * h[2] + h[3] * h[3]); }
                s += __shfl_xor(s, 16); s += __shfl_xor(s, 32);
                if (fq == 0) SSQ[(size_t)r * 16 + u.pn * 4 + wc] = s; }
    }
};
struct GroupOrder {
    int per_g, nj, total, G, c;
    __device__ __forceinline__ bool next(int i, Unit& u) const { const int L = i * G + c; if (L >= total) return false; const int g = L / per_g, rem = L - g * per_g, r = rem / nj, j = rem - r * nj; u.pm = g * 4 + r; u.pn = g * nj + j; return true; }
    __device__ __forceinline__ void a_ready(const Unit&) const {}
    __device__ __forceinline__ void done(const Unit&) const {}
};
}

namespace pg8 {
template <class Epi, class Sched>
__device__ __forceinline__ void gemm_phase_ref(const Gemm g, const Sched& S, const Epi& E) {
    const int tid = threadIdx.x, wid = __builtin_amdgcn_readfirstlane(tid >> 6), lane = tid & 63, wr = wid >> 2, wc = wid & 3, fr = lane & 15, fq = lane >> 4;
    Unit u;
    for (int ui = 0; S.next(ui, u); ++ui) {
        f32x4 acc[2][2][4][2];
#pragma unroll
        for (int a = 0; a < 2; ++a)
#pragma unroll
            for (int b = 0; b < 2; ++b)
#pragma unroll
                for (int m = 0; m < 4; ++m)
#pragma unroll
                    for (int n = 0; n < 2; ++n) acc[a][b][m][n] = (f32x4){0.f, 0.f, 0.f, 0.f};
        const bf16_t* Ab = g.A + (size_t)u.pm * 256 * g.lda + (size_t)(wr * 64 + fr) * g.lda;
        const bf16_t* Bb = g.Bt + (size_t)u.pn * 256 * g.ldb + (size_t)(wc * 32) * g.ldb;
        for (int k = 0; k < g.K; k += 8) {
#pragma unroll
            for (int ai = 0; ai < 2; ++ai) {
                f32x4 a0[4], a1[4];
#pragma unroll
                for (int m = 0; m < 4; ++m) unpack8(*(const u32x4*)(Ab + (size_t)(ai * 128 + m * 16) * g.lda + k), a0[m], a1[m]);
#pragma unroll
                for (int bj = 0; bj < 2; ++bj)
#pragma unroll
                    for (int n = 0; n < 2; ++n)
#pragma unroll
                        for (int e = 0; e < 4; ++e) {
                            const int col = bj * 128 + (Epi::PERM ? 8 * fq + 4 * n + e : 16 * n + 4 * fq + e);
                            f32x4 b0, b1; unpack8(*(const u32x4*)(Bb + (size_t)col * g.ldb + k), b0, b1);
#pragma unroll
                            for (int m = 0; m < 4; ++m) { const f32x4 p = a0[m] * b0 + a1[m] * b1; acc[ai][bj][m][n][e] += (p[0] + p[1]) + (p[2] + p[3]); }
                        }
                asm volatile("" ::: "memory");
            }
        }
        E(acc, u, wr, wc, fr, fq);
    }
}
}
#ifndef REFMASK
#define REFMASK 0x0
#endif
#define RUN_GEMM(PH, EPI, SCHED, g, S, Ep) do { if constexpr ((REFMASK >> (PH)) & 1) pg8::gemm_phase_ref<EPI, SCHED>(g, S, Ep); else pg8::gemm_phase<EPI, SCHED, true, true>(lds, g, S, Ep); } while (0)
constexpr int NWAVES = 8, NTHR = 512;
constexpr int M = 32768, D = 1024, SEQ = 4096, NIN = 8192, NG = 64, KA = 768;
constexpr float EPS = 1e-6f;
constexpr size_t MiB = 1u << 20;
constexpr size_t WS_BAR = 512 * 1024  , WS_AT = 0, WS_SSQ = 1 * MiB, WS_WIN = 4 * MiB, WS_WGLU = 20 * MiB, WS_WA = 22 * MiB, WS_WB = 24 * MiB, WS_WOUT = 26 * MiB, WS_PT = 28 * MiB, WS_MQT = 44 * MiB;
constexpr size_t WS_XN = 96 * MiB  , WS_ACAT = 160 * MiB  , WS_E = 256 * MiB  ;
constexpr size_t WS_CV = 288 * MiB  , WS_BZ = 352 * MiB  , WS_YB = 416 * MiB  , WS_END = 480 * MiB;
constexpr int LDS_BYTES = 147456;
#define LAS __attribute__((address_space(3)))
typedef unsigned short bf16;
typedef unsigned v4u __attribute__((ext_vector_type(4)));
typedef float f32x4 __attribute__((ext_vector_type(4)));
#define LDS_WAIT() asm volatile("s_waitcnt lgkmcnt(0)" ::: "memory")
__device__ __forceinline__ unsigned pk2(float lo, float hi) { return pg8::cvt_pk_bf16(lo, hi); }
__device__ __forceinline__ float wave_sum(float v) {
#pragma unroll
    for (int o = 1; o < 64; o <<= 1) v += __shfl_xor(v, o);
    return v;
}
__device__ __forceinline__ int win_src(int j) {
    const int pn = j >> 8, jj = j & 255;
    if (pn < 4) return pn * 256 + jj;
    if (pn < 12) { const int q = pn - 4; return jj < 128 ? 2048 + q * 128 + jj : 4096 + q * 128 + (jj - 128); }
    if (pn < 20) { const int q = pn - 12; return jj < 128 ? 3072 + q * 128 + jj : 5120 + q * 128 + (jj - 128); }
    if (pn < 24) return 1024 + (pn - 20) * 256 + jj;
    if (pn < 28) return 6144 + (pn - 24) * 256 + jj;
    return 7168 + (pn - 28) * 256 + jj;
}
__device__ __forceinline__ void p0_transpose_item(const float* W, int ldw, int src_col0, bf16* WT, int K, int dst_row0, int k0, LAS float* scr, int lane) {
#pragma unroll 8
    for (int i = 0; i < 32; ++i) { const int kk = 2 * i + (lane >> 5); scr[kk * 33 + (lane & 31)] = W[(size_t)(k0 + kk) * ldw + src_col0 + (lane & 31)]; }
    LDS_WAIT(); asm volatile("" ::: "memory");
    const int c = lane & 7;
#pragma unroll
    for (int j = 0; j < 4; ++j) { const int n = (lane >> 3) + 8 * j; const LAS float* s = scr + (8 * c) * 33 + n;
        v4u o; o.x = pk2(s[0 * 33], s[1 * 33]); o.y = pk2(s[2 * 33], s[3 * 33]); o.z = pk2(s[4 * 33], s[5 * 33]); o.w = pk2(s[6 * 33], s[7 * 33]);
        *(v4u*)(WT + (size_t)(dst_row0 + n) * K + k0 + 8 * c) = o; }
    LDS_WAIT(); asm volatile("" ::: "memory");
}
typedef __attribute__((address_space(1))) unsigned gu32;
#define XB_TMO      128
#define XB_XCNT(j)  (256  + 64 * (j))
#define XB_XSUB(j)  (1280 + 64 * (j))
#define XB_XGEN(j)  (2304 + 64 * (j))
#define XB_TOP      3328
#define XB_TOPGEN   3392
#define XCD_BAR_WORDS 3456
#define XB_SPIN_CAP (1u << 18)

__device__ __forceinline__ unsigned xb_ld(unsigned* p)              { return __hip_atomic_load(p, __ATOMIC_RELAXED, __HIP_MEMORY_SCOPE_AGENT); }
__device__ __forceinline__ unsigned xb_add(unsigned* p, unsigned v) { return __hip_atomic_fetch_add(p, v, __ATOMIC_RELAXED, __HIP_MEMORY_SCOPE_AGENT); }
__device__ __forceinline__ unsigned xb_xcc_id() { return (unsigned)__builtin_amdgcn_s_getreg((3 << 11) | 20) & 0xFu; }
#define XB_SPIN(cond, bar) do { unsigned _sp = 0; while (cond) { __builtin_amdgcn_s_sleep(1); \
    if ((++_sp & 255u) == 0u) { if (xb_ld(&(bar)[XB_TMO])) break; if (_sp > XB_SPIN_CAP) { atomicAdd(&(bar)[XB_TMO], 1u); break; } } } } while (0)

struct XcdBarrier {
    unsigned* bar; unsigned x;
    volatile LAS unsigned* st;
};

__device__ __forceinline__ XcdBarrier xcd_barrier_post(unsigned* bar, volatile LAS unsigned* st) {
    XcdBarrier b; b.bar = bar; b.x = xb_xcc_id(); b.st = st;
    if (threadIdx.x == 0) (void)xb_add(&bar[XB_XCNT(b.x)], 1u);
    return b;
}
__device__ __forceinline__ void xcd_barrier_complete(unsigned* bar, unsigned x, unsigned& nloc, unsigned& nx) {
    const unsigned G = gridDim.x * gridDim.y * gridDim.z;
    unsigned sum, cnt, mine, sp = 0u;
    for (;;) {
        sum = 0u; cnt = 0u; mine = 0u;
#pragma unroll
        for (unsigned j = 0; j < 16; ++j) { const unsigned c = xb_ld(&bar[XB_XCNT(j)]); sum += c; cnt += (c > 0u) ? 1u : 0u; mine = (j == x) ? c : mine; }
        if (sum == G) break;
        __builtin_amdgcn_s_sleep(1);
        if ((++sp & 255u) == 0u) { if (xb_ld(&bar[XB_TMO])) break; if (sp > XB_SPIN_CAP) { atomicAdd(&bar[XB_TMO], 1u); break; } }
    }
    nloc = mine > 0u ? mine : 1u; nx = cnt > 0u ? cnt : 1u;
}

__device__ __forceinline__ void xcd_barrier(const XcdBarrier& b) {
    asm volatile("s_waitcnt vmcnt(0)" ::: "memory");
    __syncthreads();
    if (threadIdx.x == 0) {
        unsigned* bar = b.bar;
        __builtin_amdgcn_s_waitcnt(0);
        unsigned nloc = b.st[0], nx = b.st[1];
        if (nloc == 0u) { xcd_barrier_complete(bar, b.x, nloc, nx); b.st[0] = nloc; b.st[1] = nx; }
        const unsigned old = xb_add(&bar[XB_XSUB(b.x)], 1u);
        const unsigned gen = old / nloc;
        if (old + 1u == (gen + 1u) * nloc) {
            __builtin_amdgcn_fence(__ATOMIC_RELEASE, "agent");
            asm volatile("s_waitcnt vmcnt(0)" ::: "memory");
            const unsigned og = xb_add(&bar[XB_TOP], 1u);
            const unsigned tg = og / nx;
            if (og + 1u == (tg + 1u) * nx) xb_add(&bar[XB_TOPGEN], 1u);
            else XB_SPIN(xb_ld(&bar[XB_TOPGEN]) == tg, bar);
            __builtin_amdgcn_fence(__ATOMIC_ACQUIRE, "agent");
            xb_add(&bar[XB_XGEN(b.x)], 1u);
            asm volatile("s_waitcnt vmcnt(0)" ::: "memory");
        } else {
            XB_SPIN(xb_ld(&bar[XB_XGEN(b.x)]) == gen, bar);
            __builtin_amdgcn_fence(__ATOMIC_ACQUIRE, "agent");
            asm volatile("s_waitcnt vmcnt(0)" ::: "memory");
        }
    }
    __syncthreads();
}

struct Args { const float* in[18]; float* out; unsigned char* ws; int ph_lo, ph_hi; };

__device__ __forceinline__ void p0_ssm_setup(const Args& a, LAS unsigned char* lds, int g, int q, int tid) {
    const float *lam_re = a.in[3], *lam_im = a.in[4], *log_dt = a.in[5], *b_re = a.in[6], *b_im = a.in[7], *c_re = a.in[8], *c_im = a.in[9], *ssm_d = a.in[10];
    LAS float* Apow = (LAS float*)lds;
    LAS float* Bb = Apow + 8704;
    LAS float* Cc = Bb + 4096;
    LAS float* Kt = Cc + 4096;
    bf16* MQt = (bf16*)(a.ws + WS_MQT); bf16* Pt = (bf16*)(a.ws + WS_PT); float* ATt = (float*)(a.ws + WS_AT);
    if (tid < 128) {
        const int dir = tid >> 6, p = tid & 63, gi = dir * 64 + g;
        const float dt = expf(log_dt[gi]), lr = lam_re[gi * 64 + p], li = lam_im[gi * 64 + p];
        const float mag = expf(lr * dt), th = li * dt, k = rintf(th * 0.15915494309f);
        float r = fmaf(-k, 6.2831854820251465f, th); r = fmaf(-k, -1.7484555e-7f, r);
        const float Ar = mag * cosf(r), Ai = mag * sinf(r);
        float pr = 1.f, pi = 0.f; const int base = (dir * 64 + p) * 34;
        for (int d = 0; d <= 32; ++d) { Apow[(base + d) * 2] = pr; Apow[(base + d) * 2 + 1] = pi; const float nr_ = pr * Ar - pi * Ai, ni_ = pr * Ai + pi * Ar; pr = nr_; pi = ni_; }
        const float den = lr * lr + li * li, nr = Ar - 1.0f, ni = Ai, cr = (nr * lr + ni * li) / den, ci = (ni * lr - nr * li) / den;
        for (int h = 0; h < 16; ++h) { const float br = b_re[(gi * 64 + p) * 16 + h], bi = b_im[(gi * 64 + p) * 16 + h];
            Bb[((dir * 64 + p) * 16 + h) * 2] = cr * br - ci * bi; Bb[((dir * 64 + p) * 16 + h) * 2 + 1] = cr * bi + ci * br; }
    }
    for (int idx = tid; idx < 2048; idx += NTHR) { const int dir = idx >> 10, rem = idx & 1023; Cc[idx * 2] = c_re[(dir * 64 + g) * 1024 + rem]; Cc[idx * 2 + 1] = c_im[(dir * 64 + g) * 1024 + rem]; }
    __syncthreads();
    {
        const int hh = tid & 255, h = hh >> 4, hp = hh & 15, dir = tid >> 8;
        float acc[32];
#pragma unroll
        for (int d = 0; d < 32; ++d) acc[d] = 0.f;
        for (int p = 0; p < 64; ++p) {
            const float Cr = Cc[((dir * 16 + h) * 64 + p) * 2], Ci = Cc[((dir * 16 + h) * 64 + p) * 2 + 1], Br = Bb[((dir * 64 + p) * 16 + hp) * 2], Bi = Bb[((dir * 64 + p) * 16 + hp) * 2 + 1];
            const float Wr = Cr * Br - Ci * Bi, Wi = Cr * Bi + Ci * Br;
            const LAS float* ap = Apow + (dir * 64 + p) * 68;
#pragma unroll
            for (int d = 0; d < 32; ++d) acc[d] += Wr * ap[2 * d] - Wi * ap[2 * d + 1];
        }
#pragma unroll
        for (int d = 0; d < 32; ++d) Kt[((dir * 32 + d) * 16 + h) * 16 + hp] = acc[d];
    }
    __syncthreads();
    for (int idx = tid; idx < 128 * 96; idx += NTHR) {
        const int rowl = idx / 96, ch = idx - rowl * 96, i = 8 * q + (rowl >> 4), h = rowl & 15;
        float v[8];
        if (ch < 64) {
            const int j = ch >> 1, h0 = (ch & 1) * 8;
            if (j != i) { const LAS float* src = Kt + (((j < i ? (i - j) : 32 + (j - i)) * 16 + h) * 16 + h0);
#pragma unroll
                for (int k = 0; k < 8; ++k) v[k] = src[k];
            } else { const LAS float* s0 = Kt + (h * 16 + h0); const LAS float* s1 = Kt + ((32 * 16 + h) * 16 + h0); const float dv = ssm_d[g * 16 + h];
#pragma unroll
                for (int k = 0; k < 8; ++k) v[k] = s0[k] + s1[k] + ((h0 + k) == h ? dv : 0.f);
            }
        } else {
            const int sc0 = (ch - 64) * 8, dir = sc0 >> 7, p0 = (sc0 & 127) >> 1, e = dir ? 32 - i : i + 1;
#pragma unroll
            for (int k = 0; k < 4; ++k) { const int p = p0 + k; const float Ar = Apow[((dir * 64 + p) * 34 + e) * 2], Ai = Apow[((dir * 64 + p) * 34 + e) * 2 + 1];
                const float Cr = Cc[((dir * 16 + h) * 64 + p) * 2], Ci = Cc[((dir * 16 + h) * 64 + p) * 2 + 1];
                v[2 * k] = Cr * Ar - Ci * Ai; v[2 * k + 1] = -(Cr * Ai + Ci * Ar); }
        }
        v4u o; o.x = pk2(v[0], v[1]); o.y = pk2(v[2], v[3]); o.z = pk2(v[4], v[5]); o.w = pk2(v[6], v[7]);
        *(v4u*)(MQt + ((size_t)(g * 512 + i * 16 + h) * KA + ch * 8)) = o;
    }
    for (int idx = tid; idx < 64 * 64; idx += NTHR) {
        const int scl = idx >> 6, ch = idx & 63, sc = 64 * q + scl, dir = sc >> 7, p = (sc & 127) >> 1, ri = sc & 1, j = ch >> 1, h0 = (ch & 1) * 8, e = dir ? j : 31 - j;
        const float Ar = Apow[((dir * 64 + p) * 34 + e) * 2], Ai = Apow[((dir * 64 + p) * 34 + e) * 2 + 1];
        float v[8];
#pragma unroll
        for (int k = 0; k < 8; ++k) { const float Br = Bb[((dir * 64 + p) * 16 + h0 + k) * 2], Bi = Bb[((dir * 64 + p) * 16 + h0 + k) * 2 + 1]; v[k] = ri ? (Ar * Bi + Ai * Br) : (Ar * Br - Ai * Bi); }
        v4u o; o.x = pk2(v[0], v[1]); o.y = pk2(v[2], v[3]); o.z = pk2(v[4], v[5]); o.w = pk2(v[6], v[7]);
        *(v4u*)(Pt + ((size_t)(g * 256 + sc) * 512 + ch * 8)) = o;
    }
    if (q == 0 && tid < 128) { const int dir = tid >> 6, p = tid & 63; ATt[((g * 2 + dir) * 64 + p) * 2] = Apow[((dir * 64 + p) * 34 + 32) * 2]; ATt[((g * 2 + dir) * 64 + p) * 2 + 1] = Apow[((dir * 64 + p) * 34 + 32) * 2 + 1]; }
    __syncthreads();
}

__global__ void __launch_bounds__(NTHR, 2) s5conv_fwd(Args a) {
    extern __shared__ __attribute__((aligned(16))) unsigned char lds_raw[];
    LAS unsigned char* lds = (LAS unsigned char*)lds_raw;
    cg::grid_group grid = cg::this_grid();
    const int tid = threadIdx.x, lane = tid & 63, wave = __builtin_amdgcn_readfirstlane(tid >> 6);
    const int G = gridDim.x, bx = blockIdx.x;
    const int gw = bx * NWAVES + wave, NGW = G * NWAVES;
    unsigned char* ws = a.ws;
    bf16 *WinT = (bf16*)(ws + WS_WIN), *WgluT = (bf16*)(ws + WS_WGLU), *WaT = (bf16*)(ws + WS_WA), *WbT = (bf16*)(ws + WS_WB), *WoutT = (bf16*)(ws + WS_WOUT);
    bf16 *Pt = (bf16*)(ws + WS_PT), *MQt = (bf16*)(ws + WS_MQT), *XN = (bf16*)(ws + WS_XN), *YA = (bf16*)(ws + WS_XN), *MG = (bf16*)(ws + WS_XN), *ACAT = (bf16*)(ws + WS_ACAT), *E = (bf16*)(ws + WS_E);
    bf16 *SZA = (bf16*)(ws + WS_ACAT), *SGB = (bf16*)(ws + WS_ACAT + 64 * MiB), *CV = (bf16*)(ws + WS_CV), *GY = (bf16*)(ws + WS_CV), *OA = (bf16*)(ws + WS_CV), *BZ = (bf16*)(ws + WS_BZ), *SGA = (bf16*)(ws + WS_BZ), *YB = (bf16*)(ws + WS_YB);
    float* SSQ = (float*)(ws + WS_SSQ);
    const int lo = a.ph_lo, hi = a.ph_hi;
    volatile LAS unsigned* MISC = (volatile LAS unsigned*)(lds + 140000);
    if (tid < 2) MISC[tid] = 0u;
    __syncthreads();
    XcdBarrier xbar = xcd_barrier_post((unsigned*)(ws + WS_BAR), MISC);
#define IN(k) (lo <= (k) && (k) < hi)
#define SEAM(k) do { if (IN(k) && IN((k) + 1)) { if ((k) == 0) grid.sync(); else xcd_barrier(xbar); } } while (0)

    if (IN(0)) {
        for (int u = bx; u < NG * 4; u += G) p0_ssm_setup(a, lds, u >> 2, u & 3, tid);
        LAS float* scr = (LAS float*)(lds + wave * 16384);
        for (int it = gw; it < 4096 + 4 * 512; it += NGW) {
            if (it < 4096) { const int kb = it >> 8, nb = it & 255; p0_transpose_item(a.in[2], NIN, win_src(nb * 32), WinT, D, nb * 32, kb * 64, scr, lane); }
            else { const int r = it - 4096, w = r >> 9, kb = (r & 511) >> 5, nb = r & 31;
                const float* W = w == 0 ? a.in[11] : w == 1 ? a.in[14] : w == 2 ? a.in[15] : a.in[16]; bf16* WT = w == 0 ? WgluT : w == 1 ? WaT : w == 2 ? WbT : WoutT;
                p0_transpose_item(W, D, nb * 32, WT, D, nb * 32, kb * 64, scr, lane); }
        }
        const float* ng = a.in[1];
        f32x4 gv[4];
#pragma unroll
        for (int j = 0; j < 4; ++j) gv[j] = *((const f32x4*)ng + lane + 64 * j);
        for (int m = gw; m < M; m += NGW) {
            const f32x4* xr = (const f32x4*)(a.in[0] + (size_t)m * D) + lane; f32x4 v[4]; float s = 0.f;
#pragma unroll
            for (int j = 0; j < 4; ++j) { v[j] = xr[64 * j]; s += (v[j].x * v[j].x + v[j].y * v[j].y) + (v[j].z * v[j].z + v[j].w * v[j].w); }
            const float rs = 1.0f / sqrtf(wave_sum(s) * (1.f / D) + EPS);
            unsigned long long* o8 = (unsigned long long*)(XN + (size_t)m * D) + lane;
#pragma unroll
            for (int j = 0; j < 4; ++j) { const f32x4 t = v[j] * rs * gv[j]; o8[64 * j] = (unsigned long long)pk2(t.x, t.y) | ((unsigned long long)pk2(t.z, t.w) << 32); }
        }
    }
    SEAM(0);
    if (IN(1)) {
        pg8::Gemm g{XN, WinT, D, D, D}; pg8::StaticOrder S; S.init(M, 20 * 256, G, bx);
        pg8::EpiP1 Ep{ACAT, SZA, CV, BZ, SGA, SGB, 0};
        RUN_GEMM(1, pg8::EpiP1, pg8::StaticOrder, g, S, Ep);
    }
    SEAM(1);
    if (IN(2)) {
        pg8::Gemm g{ACAT, Pt, KA, 512, 512}; pg8::GroupOrder S{4, 1, NG * 4, G, bx};
        pg8::EpiE Ep{E};
        RUN_GEMM(2, pg8::EpiE, pg8::GroupOrder, g, S, Ep);
    }
    SEAM(2);
    if (IN(3)) {
        const float* ATt = (const float*)(ws + WS_AT);
        if (wave < 4) for (int w = bx * 4 + wave; w < NG * 8 * 2; w += G * 4) {
            const int g = w >> 4, b = (w >> 1) & 7, dir = w & 1, p = lane;
            const float ar = ATt[((g * 2 + dir) * 64 + p) * 2], ai = ATt[((g * 2 + dir) * 64 + p) * 2 + 1];
            const size_t n0 = (size_t)g * 1024 + b * 128;
            const unsigned* __restrict__ Ep = (const unsigned*)(E + n0 * 256 + dir * 128) + p;
            unsigned* __restrict__ Sp = (unsigned*)(ACAT + n0 * KA + 512 + dir * 128) + p;
            float sr = 0.f, si = 0.f;
            Sp[dir ? (size_t)127 * 384 : 0] = 0u;
            for (int k0 = 0; k0 < 128; k0 += 16) {
                unsigned e[16];
#pragma unroll
                for (int i = 0; i < 16; ++i) { const int k = k0 + i, c = dir ? 127 - k : k; e[i] = (k < 127) ? Ep[(size_t)c * 128] : 0u; }
#pragma unroll
                for (int i = 0; i < 16; ++i) { const int k = k0 + i, c = dir ? 127 - k : k;
                    if (k < 127) { const float er = __uint_as_float(e[i] << 16), ei = __uint_as_float(e[i] & 0xffff0000u);
                        const float nr = ar * sr - ai * si + er, ni = ar * si + ai * sr + ei; sr = nr; si = ni; Sp[(size_t)(dir ? c - 1 : c + 1) * 384] = pk2(sr, si); } }
            }
        }
        {
            const int gt = bx * NTHR + tid, ch = gt & 127; const float *cw = a.in[12], *cb = a.in[13];
            f32x4 w0[2], w1[2], w2[2], bb[2];
#pragma unroll
            for (int k = 0; k < 2; ++k) { w0[k] = *(const f32x4*)(cw + ch * 8 + 4 * k); w1[k] = *(const f32x4*)(cw + D + ch * 8 + 4 * k); w2[k] = *(const f32x4*)(cw + 2 * D + ch * 8 + 4 * k); bb[k] = *(const f32x4*)(cb + ch * 8 + 4 * k); }
            for (int it = gt; it < M * 128; it += G * NTHR) {
                const int r = it >> 7, t = r & (SEQ - 1); const size_t off = (size_t)r * D + ch * 8;
                f32x4 c0a, c0b, c1a, c1b, c2a, c2b, za, zb;
                const v4u zero = (v4u){0u, 0u, 0u, 0u};
                pg8::unpack8(t > 0 ? *(const v4u*)(CV + off - D) : zero, c0a, c0b); pg8::unpack8(*(const v4u*)(CV + off), c1a, c1b); pg8::unpack8(t < SEQ - 1 ? *(const v4u*)(CV + off + D) : zero, c2a, c2b);
                pg8::unpack8(*(const v4u*)(BZ + off), za, zb);
                const f32x4 ya = za * (bb[0] + w0[0] * c0a + w1[0] * c1a + w2[0] * c2a), yb = zb * (bb[1] + w0[1] * c0b + w1[1] * c1b + w2[1] * c2b);
                *(v4u*)(YB + off) = pg8::pack8(ya, yb);
            }
        }
    }
    SEAM(3);
    if (IN(4)) {
        pg8::Gemm g{ACAT, MQt, KA, KA, KA}; pg8::GroupOrder S{8, 2, NG * 8, G, bx};
        pg8::EpiY Ep{GY};
        RUN_GEMM(4, pg8::EpiY, pg8::GroupOrder, g, S, Ep);
    }
    SEAM(4);
    if (IN(5)) {
        pg8::Gemm g{XN, WinT + (size_t)20 * 256 * D, D, D, D}; pg8::StaticOrder S; S.init(M, 12 * 256, G, bx);
        pg8::EpiP1 Ep{ACAT, SZA, CV, BZ, SGA, SGB, 20};
        RUN_GEMM(5, pg8::EpiP1, pg8::StaticOrder, g, S, Ep);
    }
    SEAM(5);
    if (IN(6)) {
        pg8::Gemm g{GY, WgluT, D, D, D}; pg8::StaticOrder S; S.init(M, D, G, bx);
        pg8::EpiGLU Ep{GY, SZA, YA};
        RUN_GEMM(6, pg8::EpiGLU, pg8::StaticOrder, g, S, Ep);
    }
    SEAM(6);
    if (IN(7)) {
        pg8::Gemm g{YA, WaT, D, D, D}; pg8::StaticOrder S; S.init(M, D, G, bx);
        pg8::EpiGate<false> Ep{SGA, nullptr, OA};
        RUN_GEMM(7, pg8::EpiGate<false>, pg8::StaticOrder, g, S, Ep);
    }
    SEAM(7);
    if (IN(8)) {
        pg8::Gemm g{YB, WbT, D, D, D}; pg8::StaticOrder S; S.init(M, D, G, bx);
        pg8::EpiGate<true> Ep{SGB, OA, MG};
        RUN_GEMM(8, pg8::EpiGate<true>, pg8::StaticOrder, g, S, Ep);
    }
    SEAM(8);
    if (IN(9)) {
        pg8::Gemm g{MG, WoutT, D, D, D}; pg8::StaticOrder S; S.init(M, D, G, bx);
        pg8::EpiOut Ep{a.in[0], a.out, SSQ};
        RUN_GEMM(9, pg8::EpiOut, pg8::StaticOrder, g, S, Ep);
    }
    SEAM(9);
    if (IN(10)) {
        const float* fg = a.in[17];
        f32x4 gv[4];
#pragma unroll
        for (int j = 0; j < 4; ++j) gv[j] = *((const f32x4*)fg + lane + 64 * j);
        for (int m = gw; m < M; m += NGW) {
            float s = SSQ[(size_t)m * 16 + (lane & 15)];
            s += __shfl_xor(s, 1); s += __shfl_xor(s, 2); s += __shfl_xor(s, 4); s += __shfl_xor(s, 8);
            const float rs = 1.0f / sqrtf(s * (1.f / D) + EPS);
            f32x4* hr = (f32x4*)(a.out + (size_t)m * D) + lane;
#pragma unroll
            for (int j = 0; j < 4; ++j) hr[64 * j] = hr[64 * j] * rs * gv[j];
        }
    }
#undef IN
#undef SEAM
}

#ifndef MK_PER_PHASE
#define MK_PER_PHASE 0
#endif
constexpr int N_PHASES = 11;
extern "C" void kernel_launch(void* const* d_in, const int* in_sizes, int n_in, void* d_out, int out_size, void* d_ws, size_t ws_size, hipStream_t stream) {
    static int grid = 0;
    if (grid == 0) {
        if (n_in != 18 || in_sizes[0] != M * D || out_size != M * D || ws_size < WS_END) { fprintf(stderr, "kernel_launch: unexpected shapes (n_in %d, in0 %d, out %d, ws %zu)\n", n_in, n_in > 0 ? in_sizes[0] : -1, out_size, ws_size); grid = -1; return; }
        int dev = 0, cus = 0, per_cu = 0;
        if (hipGetDevice(&dev) != hipSuccess || hipDeviceGetAttribute(&cus, hipDeviceAttributeMultiprocessorCount, dev) != hipSuccess) { grid = -1; return; }
        if (hipFuncSetAttribute((const void*)s5conv_fwd, hipFuncAttributeMaxDynamicSharedMemorySize, LDS_BYTES) != hipSuccess) { fprintf(stderr, "kernel_launch: hipFuncSetAttribute failed\n"); grid = -1; return; }
        if (hipOccupancyMaxActiveBlocksPerMultiprocessor(&per_cu, (const void*)s5conv_fwd, NTHR, LDS_BYTES) != hipSuccess || per_cu < 1) { fprintf(stderr, "kernel_launch: occupancy query says %d\n", per_cu); per_cu = 1; }
        (void)hipGetLastError();
        grid = cus * 1;
    }
    if (grid < 0) return;
    Args a{};
    for (int i = 0; i < 18; ++i) a.in[i] = (const float*)d_in[i];
    a.out = (float*)d_out; a.ws = (unsigned char*)d_ws;
#if MK_PER_PHASE
    for (int ph = 0; ph < N_PHASES; ++ph) { a.ph_lo = ph; a.ph_hi = ph + 1; hipLaunchKernelGGL(s5conv_fwd, dim3(grid), dim3(NTHR), LDS_BYTES, stream, a); }
#else
    a.ph_lo = 0; a.ph_hi = N_PHASES;
    if (hipMemsetAsync((char*)d_ws + WS_BAR, 0, XCD_BAR_WORDS * 4, stream) != hipSuccess) { fprintf(stderr, "kernel_launch: memset of the barrier words failed\n"); return; }
    void* args[] = {&a};
    hipError_t e = hipLaunchCooperativeKernel((const void*)s5conv_fwd, dim3(grid), dim3(NTHR), args, LDS_BYTES, stream);
    if (e != hipSuccess) fprintf(stderr, "kernel_launch: cooperative launch failed: %s (grid %d)\n", hipGetErrorString(e), grid);
#endif
}
```

```cpp
#include <hip/hip_runtime.h>
#include <hip/hip_cooperative_groups.h>
#include <cstdio>
#include <cstdint>
namespace cg = cooperative_groups;
namespace pg8 {
#define PG8_LAS __attribute__((address_space(3)))
typedef unsigned short bf16_t;
typedef short bf16x8 __attribute__((ext_vector_type(8)));
typedef float f32x4 __attribute__((ext_vector_type(4)));
typedef unsigned u32x4 __attribute__((ext_vector_type(4)));
constexpr int BM = 256, BK = 64, HALF = 128, HTB = HALF * BK * 2  , STAGE_BYTES = 8 * HTB, NXCD = 8, WGM = 8;

__host__ __device__ __forceinline__ int lds_byte(int r, int c) { const int st = (r >> 4) * 2 + (c >> 5), rr = r & 15, cc = c & 31, ob = rr * 64 + cc * 2; return st * 1024 + (ob ^ (((ob >> 9) & 1) << 5)); }
__host__ __device__ __forceinline__ void stage_rc(int b, int& R, int& C) { const int st = b / 1024, sb = b % 1024, swz = sb ^ (((sb >> 9) & 1) << 5); R = (st >> 1) * 16 + swz / 64; C = (st & 1) * 32 + (swz % 64) / 2; }
__host__ __device__ __forceinline__ int perm32(int rho) { const int n = rho >> 4, i = rho & 15; return 8 * (i >> 2) + 4 * n + (i & 3); }

struct Unit { int pm, pn, kind; };
struct Gemm { const bf16_t* A; const bf16_t* Bt; int lda, ldb, K; };

struct StaticOrder {
    int nM, nN, nwg, G, c;
    __host__ __device__ void init(int M, int N, int G_, int c_) { nM = M / BM; nN = N / BM; nwg = nM * nN; G = G_; c = c_; }
    __host__ __device__ bool next(int i, Unit& u) const {
        const long L = (long)i * G + c; if (L >= nwg) return false;
        int wgid = (int)L; { const int q = nwg / NXCD, r = nwg % NXCD, xcd = wgid % NXCD, off = wgid / NXCD; wgid = (xcd < r ? xcd * (q + 1) : r * (q + 1) + (xcd - r) * q) + off; }
        const int nig = WGM * nN, gid = wgid / nig, fm = gid * WGM, gsz = (nM - fm) < WGM ? (nM - fm) : WGM;
        u.pm = fm + ((wgid % nig) % gsz); u.pn = (wgid % nig) / gsz; u.kind = 0; return true;
    }
    __device__ __forceinline__ void a_ready(const Unit&) const {}
    __device__ __forceinline__ void done(const Unit&) const {}
    __device__ __forceinline__ const char* abase(const Gemm& g, const Unit& u) const { return (const char*)g.A + (size_t)u.pm * 512 * g.lda; }
    __device__ __forceinline__ const char* bbase(const Gemm& g, const Unit& u) const { return (const char*)g.Bt + (size_t)u.pn * 512 * g.ldb; }
    __device__ __forceinline__ bool keep(const Unit&) const { return false; }
};

template <class Epi, class Sched, bool ALIGN_EPI = false, bool SP2 = false>
__device__ __forceinline__ void gemm_phase(PG8_LAS unsigned char* lds, const Gemm g, const Sched& S, const Epi& E) {
    const int tid = threadIdx.x, wid = __builtin_amdgcn_readfirstlane(tid >> 6), lane = tid & 63, wr = wid >> 2, wc = wid & 3, fr = lane & 15, fq = lane >> 4;
    const int K = g.K, nt = K / BK;
    unsigned voffA[2], voffB[2];
#pragma unroll
    for (int i = 0; i < 2; ++i) { int R, C; stage_rc(tid * 16 + i * 8192, R, C); const int Rb = Epi::PERM ? ((R & ~31) + perm32(R & 31)) : R;
        voffA[i] = (unsigned)(R * g.lda + C) * 2u; voffB[i] = (unsigned)(Rb * g.ldb + C) * 2u; }
    const size_t kstep = (size_t)(BK * 2);
    const size_t hstepA = (size_t)HALF * g.lda * 2, hstepB = (size_t)HALF * g.ldb * 2;
    const unsigned ldsw = (unsigned)wid * 1024u;
    const int aoff = lds_byte(wr * 64 + fr, fq * 8), boff = lds_byte(wc * 32 + fr, fq * 8);
#define PG8_SA(b, h) (((b) * 2 + (h)) * HTB)
#define PG8_SB(b, h) ((4 + (b) * 2 + (h)) * HTB)
#define PG8_STAGE(bufoff, gbase, voff) do { _Pragma("unroll") for (int _i = 0; _i < 2; ++_i) \
        __builtin_amdgcn_global_load_lds((const unsigned*)((const char*)(gbase) + (voff)[_i]), (PG8_LAS unsigned*)(lds + (bufoff) + ldsw + _i * 8192), 16, 0, 0); } while (0)
#define PG8_LDA(dst, b, h) do { _Pragma("unroll") for (int m = 0; m < 4; ++m) _Pragma("unroll") for (int k = 0; k < 2; ++k) dst[m][k] = *(const PG8_LAS bf16x8*)(lds + PG8_SA(b, h) + aoff + m * 2048 + k * 1024); } while (0)
#define PG8_LDB(dst, b, h) do { _Pragma("unroll") for (int n = 0; n < 2; ++n) _Pragma("unroll") for (int k = 0; k < 2; ++k) dst[n][k] = *(const PG8_LAS bf16x8*)(lds + PG8_SB(b, h) + boff + n * 2048 + k * 1024); } while (0)
#define PG8_MMA(ai, bj, At, Bt) do { __builtin_amdgcn_s_setprio(1); _Pragma("unroll") for (int m = 0; m < 4; ++m) _Pragma("unroll") for (int n = 0; n < 2; ++n) _Pragma("unroll") for (int k = 0; k < 2; ++k) \
        acc[ai][bj][m][n] = __builtin_amdgcn_mfma_f32_16x16x32_bf16(Bt[n][k], At[m][k], acc[ai][bj][m][n], 0, 0, 0); __builtin_amdgcn_s_setprio(0); } while (0)
#define PG8_WAIT_V(n) asm volatile("s_waitcnt vmcnt(" #n ")" ::: "memory")
#define PG8_WAIT_L(n) asm volatile("s_waitcnt lgkmcnt(" #n ")" ::: "memory")
#define PG8_BAR __builtin_amdgcn_s_barrier()
#define PG8_SCHED __builtin_amdgcn_sched_barrier(0)
    Unit cur, nxt; int ui = 0;
    if (!S.next(0, cur)) return;
    f32x4 acc[2][2][4][2];
#pragma unroll
    for (int a = 0; a < 2; ++a)
#pragma unroll
        for (int b = 0; b < 2; ++b)
#pragma unroll
            for (int m = 0; m < 4; ++m)
#pragma unroll
                for (int n = 0; n < 2; ++n) acc[a][b][m][n] = (f32x4){0.f, 0.f, 0.f, 0.f};
    bf16x8 At[4][2], B0[2][2], B1[2][2];
    const char* cA = S.abase(g, cur); const char* cB = S.bbase(g, cur);
    S.a_ready(cur);
    if constexpr (SP2) {
        PG8_STAGE(PG8_SB(0, 0), cB, voffB); PG8_STAGE(PG8_SB(0, 1), cB + hstepB, voffB); PG8_STAGE(PG8_SA(0, 0), cA, voffA); PG8_STAGE(PG8_SA(0, 1), cA + hstepA, voffA);
        if (wr == 1) PG8_BAR;
        PG8_WAIT_V(2); PG8_BAR;
        PG8_STAGE(PG8_SB(1, 0), cB + kstep, voffB); PG8_STAGE(PG8_SA(1, 0), cA + kstep, voffA); PG8_STAGE(PG8_SB(1, 1), cB + hstepB + kstep, voffB);
        PG8_WAIT_V(6); PG8_BAR;
    } else {
        PG8_STAGE(PG8_SB(0, 0), cB, voffB); PG8_STAGE(PG8_SA(0, 0), cA, voffA); PG8_STAGE(PG8_SB(0, 1), cB + hstepB, voffB); PG8_STAGE(PG8_SA(0, 1), cA + hstepA, voffA);
        if (wr == 1) PG8_BAR;
        PG8_WAIT_V(4); PG8_BAR;
        PG8_STAGE(PG8_SB(1, 0), cB + kstep, voffB); PG8_STAGE(PG8_SA(1, 0), cA + kstep, voffA); PG8_STAGE(PG8_SB(1, 1), cB + hstepB + kstep, voffB);
        PG8_WAIT_V(6); PG8_BAR;
    }
    for (;;) {
        const bool has_next = S.next(ui + 1, nxt);
        const char* nA = has_next ? S.abase(g, nxt) : cA; const char* nB = has_next ? S.bbase(g, nxt) : cB;
        for (int t = 0; t < nt; t += 2) {
            const bool last = (t == nt - 2);
            const char* a1 = cA + (size_t)(t + 1) * kstep;
            const char* a2 = last ? nA : cA + (size_t)(t + 2) * kstep; const char* b2 = last ? nB : cB + (size_t)(t + 2) * kstep;
            const char* a3 = a2 + kstep; const char* b3 = b2 + kstep;
            if (last && has_next) S.a_ready(nxt);
            if constexpr (SP2) {
            PG8_LDB(B0, 0, 0); PG8_LDB(B1, 0, 1); PG8_SCHED; PG8_LDA(At, 0, 0); PG8_STAGE(PG8_SA(1, 1), a1 + hstepA, voffA);
            PG8_WAIT_V(8); PG8_WAIT_L(0); PG8_BAR; PG8_MMA(0, 0, At, B0); PG8_MMA(0, 1, At, B1); PG8_BAR; PG8_SCHED;
            PG8_LDA(At, 0, 1); PG8_STAGE(PG8_SB(0, 0), b2, voffB); PG8_STAGE(PG8_SB(0, 1), b2 + hstepB, voffB); PG8_STAGE(PG8_SA(0, 0), a2, voffA);
            PG8_WAIT_V(8); PG8_WAIT_L(0); PG8_BAR; PG8_MMA(1, 0, At, B0); PG8_MMA(1, 1, At, B1); PG8_BAR; PG8_SCHED;
            PG8_LDB(B0, 1, 0); PG8_LDB(B1, 1, 1); PG8_SCHED; PG8_LDA(At, 1, 0); PG8_STAGE(PG8_SA(0, 1), a2 + hstepA, voffA);
            PG8_WAIT_V(8); PG8_WAIT_L(0); PG8_BAR; PG8_MMA(0, 0, At, B0); PG8_MMA(0, 1, At, B1); PG8_BAR; PG8_SCHED;
            PG8_LDA(At, 1, 1); PG8_STAGE(PG8_SB(1, 0), b3, voffB); PG8_STAGE(PG8_SB(1, 1), b3 + hstepB, voffB); PG8_STAGE(PG8_SA(1, 0), a3, voffA);
            PG8_WAIT_V(8); PG8_WAIT_L(0); PG8_BAR; PG8_MMA(1, 0, At, B0); PG8_MMA(1, 1, At, B1); PG8_BAR; PG8_SCHED;
            } else {
            PG8_LDB(B0, 0, 0); PG8_SCHED; PG8_LDA(At, 0, 0); PG8_STAGE(PG8_SA(1, 1), a1 + hstepA, voffA);
            PG8_WAIT_L(8); PG8_BAR; PG8_WAIT_L(0); PG8_MMA(0, 0, At, B0); PG8_BAR; PG8_SCHED;
            PG8_LDB(B1, 0, 1); PG8_STAGE(PG8_SB(0, 0), b2, voffB);
            PG8_BAR; PG8_WAIT_L(0); PG8_MMA(0, 1, At, B1); PG8_BAR;
            PG8_LDA(At, 0, 1); PG8_STAGE(PG8_SA(0, 0), a2, voffA);
            PG8_BAR; PG8_WAIT_L(0); PG8_MMA(1, 0, At, B0); PG8_BAR; PG8_SCHED;
            PG8_STAGE(PG8_SB(0, 1), b2 + hstepB, voffB);
            PG8_WAIT_V(6); PG8_BAR; PG8_MMA(1, 1, At, B1); PG8_BAR;
            PG8_LDB(B0, 1, 0); PG8_SCHED; PG8_LDA(At, 1, 0); PG8_STAGE(PG8_SA(0, 1), a2 + hstepA, voffA);
            PG8_WAIT_L(8); PG8_BAR; PG8_WAIT_L(0); PG8_MMA(0, 0, At, B0); PG8_BAR; PG8_SCHED;
            PG8_LDB(B1, 1, 1); PG8_STAGE(PG8_SB(1, 0), b3, voffB);
            PG8_BAR; PG8_WAIT_L(0); PG8_MMA(0, 1, At, B1); PG8_BAR;
            PG8_LDA(At, 1, 1); PG8_STAGE(PG8_SA(1, 0), a3, voffA);
            PG8_BAR; PG8_WAIT_L(0); PG8_MMA(1, 0, At, B0); PG8_BAR; PG8_SCHED;
            PG8_STAGE(PG8_SB(1, 1), b3 + hstepB, voffB);
            PG8_WAIT_V(6); PG8_BAR; PG8_MMA(1, 1, At, B1); PG8_BAR;
            }
        }
        if constexpr (ALIGN_EPI) { if (wr == 0) PG8_BAR; }
        if constexpr (!Epi::AFTER_DRAIN) { E(acc, cur, wr, wc, fr, fq); S.done(cur); }
        if (!has_next) break;
        if (!S.keep(cur)) {
#pragma unroll
        for (int a = 0; a < 2; ++a)
#pragma unroll
            for (int b = 0; b < 2; ++b)
#pragma unroll
                for (int m = 0; m < 4; ++m)
#pragma unroll
                    for (int n = 0; n < 2; ++n) acc[a][b][m][n] = (f32x4){0.f, 0.f, 0.f, 0.f};
        }
        cur = nxt; cA = nA; cB = nB; ++ui;
        if constexpr (ALIGN_EPI) { if (wr == 1) PG8_BAR; }
    }
    PG8_WAIT_V(0);
    if constexpr (!ALIGN_EPI) { if (wr == 0) PG8_BAR; }
    PG8_BAR;
    if constexpr (Epi::AFTER_DRAIN) { E.fused(acc, cur, wr, wc, fr, fq, lds, wid, lane); S.done(cur); }
#undef PG8_SA
#undef PG8_SB
#undef PG8_STAGE
#undef PG8_LDA
#undef PG8_LDB
#undef PG8_MMA
#undef PG8_WAIT_V
#undef PG8_WAIT_L
#undef PG8_BAR
#undef PG8_SCHED
}
}
namespace pg8 {
typedef __bf16 bf16x2n __attribute__((ext_vector_type(2)));
typedef float f32x2n __attribute__((ext_vector_type(2)));
__device__ __forceinline__ unsigned cvt_pk_bf16(float lo, float hi) { const f32x2n v = {lo, hi}; const bf16x2n b = __builtin_convertvector(v, bf16x2n); return __builtin_bit_cast(unsigned, b); }
__device__ __forceinline__ float fsig(float x) { return __builtin_amdgcn_rcpf(1.0f + __builtin_amdgcn_exp2f(-1.44269504089f * x)); }
__device__ __forceinline__ float fsilu(float x) { return x * fsig(x); }
__device__ __forceinline__ float fgelu(float y) { return y * fsig(1.59576912161f * (y + 0.044715f * y * y * y)); }
__device__ __forceinline__ f32x4 vsig(f32x4 v) { return (f32x4){fsig(v[0]), fsig(v[1]), fsig(v[2]), fsig(v[3])}; }
__device__ __forceinline__ f32x4 vsilu(f32x4 v) { return (f32x4){fsilu(v[0]), fsilu(v[1]), fsilu(v[2]), fsilu(v[3])}; }
__device__ __forceinline__ f32x4 vgelu(f32x4 v) { return (f32x4){fgelu(v[0]), fgelu(v[1]), fgelu(v[2]), fgelu(v[3])}; }
__device__ __forceinline__ u32x4 pack8(f32x4 a, f32x4 b) { u32x4 w; w.x = cvt_pk_bf16(a[0], a[1]); w.y = cvt_pk_bf16(a[2], a[3]); w.z = cvt_pk_bf16(b[0], b[1]); w.w = cvt_pk_bf16(b[2], b[3]); return w; }
__device__ __forceinline__ void unpack8(u32x4 w, f32x4& a, f32x4& b) {
    a[0] = __uint_as_float(w.x << 16); a[1] = __uint_as_float(w.x & 0xffff0000u); a[2] = __uint_as_float(w.y << 16); a[3] = __uint_as_float(w.y & 0xffff0000u);
    b[0] = __uint_as_float(w.z << 16); b[1] = __uint_as_float(w.z & 0xffff0000u); b[2] = __uint_as_float(w.w << 16); b[3] = __uint_as_float(w.w & 0xffff0000u); }

struct EpiP1 {
    static constexpr bool PERM = true, AFTER_DRAIN = false;
    bf16_t *ACAT, *SZA, *CV, *BZ, *SGA, *SGB; int pn_off;
    __device__ __forceinline__ void operator()(f32x4 (&acc)[2][2][4][2], const Unit& u, int wr, int wc, int fr, int fq) const {
        const int pn = u.pn + pn_off, row0 = u.pm * BM + wr * 64 + fr, cl = wc * 32 + 8 * fq;
        if (pn < 4) {
#pragma unroll
            for (int ai = 0; ai < 2; ++ai)
#pragma unroll
                for (int m = 0; m < 4; ++m) { const int r = row0 + ai * HALF + m * 16;
#pragma unroll
                    for (int bj = 0; bj < 2; ++bj) { const int col = pn * 256 + bj * HALF + cl, g = col >> 4, h0 = col & 15;
                        *(u32x4*)(ACAT + ((size_t)(g * 1024 + (r >> 5)) * 768 + (r & 31) * 16 + h0)) = pack8(acc[ai][bj][m][0], acc[ai][bj][m][1]); } }
        } else if (pn < 12) {
#pragma unroll
            for (int ai = 0; ai < 2; ++ai)
#pragma unroll
                for (int m = 0; m < 4; ++m) { bf16_t* rowp = CV + (size_t)(row0 + ai * HALF + m * 16) * 1024 + (pn - 4) * 128 + cl;
                    *(u32x4*)rowp = pack8(acc[ai][0][m][0] * acc[ai][1][m][0], acc[ai][0][m][1] * acc[ai][1][m][1]); }
        } else if (pn < 20) {
#pragma unroll
            for (int ai = 0; ai < 2; ++ai)
#pragma unroll
                for (int m = 0; m < 4; ++m) { bf16_t* rowp = BZ + (size_t)(row0 + ai * HALF + m * 16) * 1024 + (pn - 12) * 128 + cl;
                    *(u32x4*)rowp = pack8(acc[ai][0][m][0] * vsilu(acc[ai][1][m][0]), acc[ai][0][m][1] * vsilu(acc[ai][1][m][1])); }
        } else if (pn < 24) {
#pragma unroll
            for (int ai = 0; ai < 2; ++ai)
#pragma unroll
                for (int m = 0; m < 4; ++m) { bf16_t* rowp = SZA + (size_t)(row0 + ai * HALF + m * 16) * 1024 + (pn - 20) * 256 + cl;
#pragma unroll
                    for (int bj = 0; bj < 2; ++bj) *(u32x4*)(rowp + bj * HALF) = pack8(vsilu(acc[ai][bj][m][0]), vsilu(acc[ai][bj][m][1])); }
        } else {
#pragma unroll
            for (int ai = 0; ai < 2; ++ai)
#pragma unroll
                for (int m = 0; m < 4; ++m) { const size_t off = (size_t)(row0 + ai * HALF + m * 16) * 1024 + (pn - 24) * 128 + cl; f32x4 rr[2], sb[2];
#pragma unroll
                    for (int n = 0; n < 2; ++n)
#pragma unroll
                        for (int e = 0; e < 4; ++e) { const float ea = __builtin_amdgcn_exp2f(-1.44269504089f * acc[ai][0][m][n][e]), eb = __builtin_amdgcn_exp2f(-1.44269504089f * acc[ai][1][m][n][e]);
                            sb[n][e] = __builtin_amdgcn_rcpf(1.0f + eb); rr[n][e] = (1.0f + eb) * __builtin_amdgcn_rcpf(1.0f + ea); }
                    *(u32x4*)(SGA + off) = pack8(rr[0], rr[1]); *(u32x4*)(SGB + off) = pack8(sb[0], sb[1]); }
        }
    }
};
struct EpiE {
    static constexpr bool PERM = true, AFTER_DRAIN = false;
    bf16_t* E;
    __device__ __forceinline__ void operator()(f32x4 (&acc)[2][2][4][2], const Unit& u, int wr, int wc, int fr, int fq) const {
        const int row0 = u.pm * BM + wr * 64 + fr, cl = wc * 32 + 8 * fq;
#pragma unroll
        for (int ai = 0; ai < 2; ++ai)
#pragma unroll
            for (int m = 0; m < 4; ++m) { bf16_t* rowp = E + (size_t)(row0 + ai * HALF + m * 16) * 256 + cl;
#pragma unroll
                for (int bj = 0; bj < 2; ++bj) *(u32x4*)(rowp + bj * HALF) = pack8(acc[ai][bj][m][0], acc[ai][bj][m][1]); }
    }
};
struct EpiY {
    static constexpr bool PERM = true, AFTER_DRAIN = false;
    bf16_t* GY;
    __device__ __forceinline__ void operator()(f32x4 (&acc)[2][2][4][2], const Unit& u, int wr, int wc, int fr, int fq) const {
        const int g = u.pm >> 2, n0 = (u.pm & 3) * 256 + wr * 64 + fr, oc0 = (u.pn & 1) * 256 + wc * 32 + 8 * fq;
#pragma unroll
        for (int ai = 0; ai < 2; ++ai)
#pragma unroll
            for (int m = 0; m < 4; ++m) { const int n = n0 + ai * HALF + m * 16, b = n >> 7, c = n & 127;
#pragma unroll
                for (int bj = 0; bj < 2; ++bj) { const int oc = oc0 + bj * HALF, i = oc >> 4, h0 = oc & 15; const size_t tok = (size_t)b * 4096 + c * 32 + i;
                    *(u32x4*)(GY + tok * 1024 + g * 16 + h0) = pack8(vgelu(acc[ai][bj][m][0]), vgelu(acc[ai][bj][m][1])); } }
    }
};
struct EpiGLU {
    static constexpr bool PERM = true, AFTER_DRAIN = false;
    const bf16_t *GY, *SZA; bf16_t* YA;
    __device__ __forceinline__ void operator()(f32x4 (&acc)[2][2][4][2], const Unit& u, int wr, int wc, int fr, int fq) const {
        const int row0 = u.pm * BM + wr * 64 + fr, col0 = u.pn * BM + wc * 32 + 8 * fq;
#pragma unroll
        for (int ai = 0; ai < 2; ++ai)
#pragma unroll
            for (int m = 0; m < 4; ++m) { const size_t off = (size_t)(row0 + ai * HALF + m * 16) * 1024 + col0;
#pragma unroll
                for (int bj = 0; bj < 2; ++bj) { f32x4 g0, g1, z0, z1; unpack8(*(const u32x4*)(GY + off + bj * HALF), g0, g1); unpack8(*(const u32x4*)(SZA + off + bj * HALF), z0, z1);
                    *(u32x4*)(YA + off + bj * HALF) = pack8(g0 * vsig(acc[ai][bj][m][0]) * z0, g1 * vsig(acc[ai][bj][m][1]) * z1); } }
    }
};
struct EpiPair {
    static constexpr bool PERM = true, AFTER_DRAIN = false;
    const bf16_t *RG, *SGB; bf16_t* MG;
    __device__ __forceinline__ void operator()(f32x4 (&acc)[2][2][4][2], const Unit& u, int wr, int wc, int fr, int fq) const {
        const int row0 = u.pm * BM + wr * 64 + fr, col0 = u.pn * BM + wc * 32 + 8 * fq;
        if (u.kind == 0) {
#pragma unroll
            for (int ai = 0; ai < 2; ++ai)
#pragma unroll
                for (int m = 0; m < 4; ++m) { const size_t off = (size_t)(row0 + ai * HALF + m * 16) * 1024 + col0;
#pragma unroll
                    for (int bj = 0; bj < 2; ++bj) { f32x4 s0, s1; unpack8(*(const u32x4*)(RG + off + bj * HALF), s0, s1); acc[ai][bj][m][0] *= s0; acc[ai][bj][m][1] *= s1; } }
        } else {
#pragma unroll
            for (int ai = 0; ai < 2; ++ai)
#pragma unroll
                for (int m = 0; m < 4; ++m) { const size_t off = (size_t)(row0 + ai * HALF + m * 16) * 1024 + col0;
#pragma unroll
                    for (int bj = 0; bj < 2; ++bj) { f32x4 s0, s1; unpack8(*(const u32x4*)(SGB + off + bj * HALF), s0, s1);
                        *(u32x4*)(MG + off + bj * HALF) = pack8(s0 * acc[ai][bj][m][0], s1 * acc[ai][bj][m][1]); } }
        }
    }
};
struct PairOrder {
    StaticOrder so; const bf16_t *A1, *B1;
    __device__ __forceinline__ bool next(int i, Unit& u) const { const bool ok = so.next(i >> 1, u); u.kind = i & 1; return ok; }
    __device__ __forceinline__ void a_ready(const Unit&) const {}
    __device__ __forceinline__ void done(const Unit&) const {}
    __device__ __forceinline__ const char* abase(const Gemm& g, const Unit& u) const { return (const char*)(u.kind ? A1 : g.A) + (size_t)u.pm * 512 * g.lda; }
    __device__ __forceinline__ const char* bbase(const Gemm& g, const Unit& u) const { return (const char*)(u.kind ? B1 : g.Bt) + (size_t)u.pn * 512 * g.ldb; }
    __device__ __forceinline__ bool keep(const Unit& u) const { return u.kind == 0; }
};
struct EpiOut {
    static constexpr bool PERM = false, AFTER_DRAIN = false;
    const float* X; float* O; float* SSQ;
    __device__ __forceinline__ void operator()(f32x4 (&acc)[2][2][4][2], const Unit& u, int wr, int wc, int fr, int fq) const {
        const int row0 = u.pm * BM + wr * 64 + fr, col0 = u.pn * BM + wc * 32 + 4 * fq;
#pragma unroll
        for (int ai = 0; ai < 2; ++ai)
#pragma unroll
            for (int m = 0; m < 4; ++m) { const int r = row0 + ai * HALF + m * 16; const size_t off = (size_t)r * 1024 + col0; float s = 0.f;
#pragma unroll
                for (int bj = 0; bj < 2; ++bj)
#pragma unroll
                    for (int n = 0; n < 2; ++n) { const f32x4 h = *(const f32x4*)(X + off + bj * HALF + n * 16) + acc[ai][bj][m][n];
                        *(f32x4*)(O + off + bj * HALF + n * 16) = h; s += (h[0] * h[0] + h[1] * h[1]) + (h[2] * h[2] + h[3] * h[3]); }
                s += __shfl_xor(s, 16); s += __shfl_xor(s, 32);
                if (fq == 0) SSQ[(size_t)r * 16 + u.pn * 4 + wc] = s; }
    }
};
struct GroupOrder {
    int per_g, nj, total, G, c;
    __device__ __forceinline__ bool next(int i, Unit& u) const { const int L = i * G + c; if (L >= total) return false; const int g = L / per_g, rem = L - g * per_g, r = rem / nj, j = rem - r * nj; u.pm = g * 4 + r; u.pn = g * nj + j; u.kind = 0; return true; }
    __device__ __forceinline__ void a_ready(const Unit&) const {}
    __device__ __forceinline__ void done(const Unit&) const {}
    __device__ __forceinline__ const char* abase(const Gemm& g, const Unit& u) const { return (const char*)g.A + (size_t)u.pm * 512 * g.lda; }
    __device__ __forceinline__ const char* bbase(const Gemm& g, const Unit& u) const { return (const char*)g.Bt + (size_t)u.pn * 512 * g.ldb; }
    __device__ __forceinline__ bool keep(const Unit&) const { return false; }
};
}

#ifndef REFMASK
#define REFMASK 0x0
#endif
#define RUN_GEMM(PH, EPI, SCHED, g, S, Ep) pg8::gemm_phase<EPI, SCHED, true, true>(lds, g, S, Ep)
constexpr int NWAVES = 8, NTHR = 512;
constexpr int M = 32768, D = 1024, SEQ = 4096, NIN = 8192, NG = 64, KA = 768;
constexpr float EPS = 1e-6f;
constexpr size_t MiB = 1u << 20;
constexpr size_t WS_BAR = 512 * 1024  , WS_AT = 0, WS_SSQ = 1 * MiB, WS_WIN = 4 * MiB, WS_WGLU = 20 * MiB, WS_WA = 22 * MiB, WS_WB = 24 * MiB, WS_WOUT = 26 * MiB, WS_PT = 28 * MiB, WS_MQT = 44 * MiB;
constexpr size_t WS_XN = 96 * MiB  , WS_ACAT = 160 * MiB  , WS_E = 256 * MiB  ;
constexpr size_t WS_CV = 288 * MiB  , WS_BZ = 352 * MiB  , WS_YB = 416 * MiB  , WS_END = 480 * MiB;
constexpr int LDS_BYTES = 147456;
#define LAS __attribute__((address_space(3)))
typedef unsigned short bf16;
typedef unsigned v4u __attribute__((ext_vector_type(4)));
typedef float f32x4 __attribute__((ext_vector_type(4)));
#define LDS_WAIT() asm volatile("s_waitcnt lgkmcnt(0)" ::: "memory")
__device__ __forceinline__ unsigned pk2(float lo, float hi) { return pg8::cvt_pk_bf16(lo, hi); }
__device__ __forceinline__ float wave_sum(float v) {
#pragma unroll
    for (int o = 1; o < 64; o <<= 1) v += __shfl_xor(v, o);
    return v;
}
__device__ __forceinline__ int win_src(int j) {
    const int pn = j >> 8, jj = j & 255;
    if (pn < 4) return pn * 256 + jj;
    if (pn < 12) { const int q = pn - 4; return jj < 128 ? 2048 + q * 128 + jj : 4096 + q * 128 + (jj - 128); }
    if (pn < 20) { const int q = pn - 12; return jj < 128 ? 3072 + q * 128 + jj : 5120 + q * 128 + (jj - 128); }
    if (pn < 24) return 1024 + (pn - 20) * 256 + jj;
    { const int q = pn - 24; return jj < 128 ? 6144 + q * 128 + jj : 7168 + q * 128 + (jj - 128); }
}
__device__ __forceinline__ void p0_transpose_item(const float* W, int ldw, int src_col0, bf16* WT, int K, int dst_row0, int k0, LAS float* scr, int lane) {
    float tv[32];
#pragma unroll
    for (int i = 0; i < 32; ++i) tv[i] = W[(size_t)(k0 + 2 * i + (lane >> 5)) * ldw + src_col0 + (lane & 31)];
#pragma unroll
    for (int i = 0; i < 32; ++i) scr[(2 * i + (lane >> 5)) * 33 + (lane & 31)] = tv[i];
    LDS_WAIT(); asm volatile("" ::: "memory");
    const int c = lane & 7;
#pragma unroll
    for (int j = 0; j < 4; ++j) { const int n = (lane >> 3) + 8 * j; const LAS float* s = scr + (8 * c) * 33 + n;
        v4u o; o.x = pk2(s[0 * 33], s[1 * 33]); o.y = pk2(s[2 * 33], s[3 * 33]); o.z = pk2(s[4 * 33], s[5 * 33]); o.w = pk2(s[6 * 33], s[7 * 33]);
        *(v4u*)(WT + (size_t)(dst_row0 + n) * K + k0 + 8 * c) = o; }
    LDS_WAIT(); asm volatile("" ::: "memory");
}
typedef __attribute__((address_space(1))) unsigned gu32;
#define XB_TMO      128
#define XB_XCNT(j)  (256  + 64 * (j))
#define XB_XSUB(j)  (1280 + 64 * (j))
#define XB_XGEN(j)  (2304 + 64 * (j))
#define XB_TOP      3328
#define XB_TOPGEN   3392
#define XCD_BAR_WORDS 3456
#define XB_SPIN_CAP (1u << 18)

__device__ __forceinline__ unsigned xb_ld(unsigned* p)              { return __hip_atomic_load(p, __ATOMIC_RELAXED, __HIP_MEMORY_SCOPE_AGENT); }
__device__ __forceinline__ unsigned xb_add(unsigned* p, unsigned v) { return __hip_atomic_fetch_add(p, v, __ATOMIC_RELAXED, __HIP_MEMORY_SCOPE_AGENT); }
__device__ __forceinline__ unsigned xb_xcc_id() { return (unsigned)__builtin_amdgcn_s_getreg((3 << 11) | 20) & 0xFu; }
#define XB_SPIN(cond, bar) do { unsigned _sp = 0; while (cond) { __builtin_amdgcn_s_sleep(1); \
    if ((++_sp & 255u) == 0u) { if (xb_ld(&(bar)[XB_TMO])) break; if (_sp > XB_SPIN_CAP) { atomicAdd(&(bar)[XB_TMO], 1u); break; } } } } while (0)

struct XcdBarrier {
    unsigned* bar; unsigned x;
    volatile LAS unsigned* st;
};

__device__ __forceinline__ XcdBarrier xcd_barrier_post(unsigned* bar, volatile LAS unsigned* st) {
    XcdBarrier b; b.bar = bar; b.x = xb_xcc_id(); b.st = st;
    if (threadIdx.x == 0) (void)xb_add(&bar[XB_XCNT(b.x)], 1u);
    return b;
}
__device__ __forceinline__ void xcd_barrier_complete(unsigned* bar, unsigned x, unsigned& nloc, unsigned& nx) {
    const unsigned G = gridDim.x * gridDim.y * gridDim.z;
    unsigned sum, cnt, mine, sp = 0u;
    for (;;) {
        sum = 0u; cnt = 0u; mine = 0u;
#pragma unroll
        for (unsigned j = 0; j < 16; ++j) { const unsigned c = xb_ld(&bar[XB_XCNT(j)]); sum += c; cnt += (c > 0u) ? 1u : 0u; mine = (j == x) ? c : mine; }
        if (sum == G) break;
        __builtin_amdgcn_s_sleep(1);
        if ((++sp & 255u) == 0u) { if (xb_ld(&bar[XB_TMO])) break; if (sp > XB_SPIN_CAP) { atomicAdd(&bar[XB_TMO], 1u); break; } }
    }
    nloc = mine > 0u ? mine : 1u; nx = cnt > 0u ? cnt : 1u;
}

__device__ __forceinline__ void xcd_barrier(const XcdBarrier& b) {
    asm volatile("s_waitcnt vmcnt(0)" ::: "memory");
    __syncthreads();
    if (threadIdx.x == 0) {
        unsigned* bar = b.bar;
        __builtin_amdgcn_s_waitcnt(0);
        unsigned nloc = b.st[0], nx = b.st[1];
        if (nloc == 0u) { xcd_barrier_complete(bar, b.x, nloc, nx); b.st[0] = nloc; b.st[1] = nx; }
        const unsigned old = xb_add(&bar[XB_XSUB(b.x)], 1u);
        const unsigned gen = old / nloc;
        if (old + 1u == (gen + 1u) * nloc) {
            __builtin_amdgcn_fence(__ATOMIC_RELEASE, "agent");
            asm volatile("s_waitcnt vmcnt(0)" ::: "memory");
            const unsigned og = xb_add(&bar[XB_TOP], 1u);
            const unsigned tg = og / nx;
            if (og + 1u == (tg + 1u) * nx) xb_add(&bar[XB_TOPGEN], 1u);
            else XB_SPIN(xb_ld(&bar[XB_TOPGEN]) == tg, bar);
            __builtin_amdgcn_fence(__ATOMIC_ACQUIRE, "agent");
            xb_add(&bar[XB_XGEN(b.x)], 1u);
            asm volatile("s_waitcnt vmcnt(0)" ::: "memory");
        } else {
            XB_SPIN(xb_ld(&bar[XB_XGEN(b.x)]) == gen, bar);
            __builtin_amdgcn_fence(__ATOMIC_ACQUIRE, "agent");
            asm volatile("s_waitcnt vmcnt(0)" ::: "memory");
        }
    }
    __syncthreads();
}

struct Args { const float* in[18]; float* out; unsigned char* ws; int ph_lo, ph_hi; };

__device__ __forceinline__ void p0_ssm_setup(const Args& a, LAS unsigned char* lds, int g, int q, int tid) {
    const float *lam_re = a.in[3], *lam_im = a.in[4], *log_dt = a.in[5], *b_re = a.in[6], *b_im = a.in[7], *c_re = a.in[8], *c_im = a.in[9], *ssm_d = a.in[10];
    LAS float* Apow = (LAS float*)lds;
    LAS float* Bb = Apow + 8704;
    LAS float* Cc = Bb + 4096;
    LAS float* Kt = Cc + 4096;
    bf16* MQt = (bf16*)(a.ws + WS_MQT); bf16* Pt = (bf16*)(a.ws + WS_PT); float* ATt = (float*)(a.ws + WS_AT);
    if (tid < 128) {
        const int dir = tid >> 6, p = tid & 63, gi = dir * 64 + g;
        const float dt = expf(log_dt[gi]), lr = lam_re[gi * 64 + p], li = lam_im[gi * 64 + p];
        const float mag = expf(lr * dt), th = li * dt, k = rintf(th * 0.15915494309f);
        float r = fmaf(-k, 6.2831854820251465f, th); r = fmaf(-k, -1.7484555e-7f, r);
        const float Ar = mag * cosf(r), Ai = mag * sinf(r);
        float pr = 1.f, pi = 0.f; const int base = (dir * 64 + p) * 34;
        for (int d = 0; d <= 32; ++d) { Apow[(base + d) * 2] = pr; Apow[(base + d) * 2 + 1] = pi; const float nr_ = pr * Ar - pi * Ai, ni_ = pr * Ai + pi * Ar; pr = nr_; pi = ni_; }
        const float den = lr * lr + li * li, nr = Ar - 1.0f, ni = Ai, cr = (nr * lr + ni * li) / den, ci = (ni * lr - nr * li) / den;
        for (int h = 0; h < 16; ++h) { const float br = b_re[(gi * 64 + p) * 16 + h], bi = b_im[(gi * 64 + p) * 16 + h];
            Bb[((dir * 64 + p) * 16 + h) * 2] = cr * br - ci * bi; Bb[((dir * 64 + p) * 16 + h) * 2 + 1] = cr * bi + ci * br; }
    }
    for (int idx = tid; idx < 2048; idx += NTHR) { const int dir = idx >> 10, rem = idx & 1023; Cc[idx * 2] = c_re[(dir * 64 + g) * 1024 + rem]; Cc[idx * 2 + 1] = c_im[(dir * 64 + g) * 1024 + rem]; }
    __syncthreads();
    {
        const int hh = tid & 255, h = hh >> 4, hp = hh & 15, dir = tid >> 8;
        float acc[32];
#pragma unroll
        for (int d = 0; d < 32; ++d) acc[d] = 0.f;
        for (int p = 0; p < 64; ++p) {
            const float Cr = Cc[((dir * 16 + h) * 64 + p) * 2], Ci = Cc[((dir * 16 + h) * 64 + p) * 2 + 1], Br = Bb[((dir * 64 + p) * 16 + hp) * 2], Bi = Bb[((dir * 64 + p) * 16 + hp) * 2 + 1];
            const float Wr = Cr * Br - Ci * Bi, Wi = Cr * Bi + Ci * Br;
            const LAS float* ap = Apow + (dir * 64 + p) * 68;
#pragma unroll
            for (int d = 0; d < 32; ++d) acc[d] += Wr * ap[2 * d] - Wi * ap[2 * d + 1];
        }
#pragma unroll
        for (int d = 0; d < 32; ++d) Kt[((dir * 32 + d) * 16 + h) * 16 + hp] = acc[d];
    }
    __syncthreads();
    for (int idx = tid; idx < 128 * 96; idx += NTHR) {
        const int rowl = idx / 96, ch = idx - rowl * 96, i = 8 * q + (rowl >> 4), h = rowl & 15;
        float v[8];
        if (ch < 64) {
            const int j = ch >> 1, h0 = (ch & 1) * 8;
            if (j != i) { const LAS float* src = Kt + (((j < i ? (i - j) : 32 + (j - i)) * 16 + h) * 16 + h0);
#pragma unroll
                for (int k = 0; k < 8; ++k) v[k] = src[k];
            } else { const LAS float* s0 = Kt + (h * 16 + h0); const LAS float* s1 = Kt + ((32 * 16 + h) * 16 + h0); const float dv = ssm_d[g * 16 + h];
#pragma unroll
                for (int k = 0; k < 8; ++k) v[k] = s0[k] + s1[k] + ((h0 + k) == h ? dv : 0.f);
            }
        } else {
            const int sc0 = (ch - 64) * 8, dir = sc0 >> 7, p0 = (sc0 & 127) >> 1, e = dir ? 32 - i : i + 1;
#pragma unroll
            for (int k = 0; k < 4; ++k) { const int p = p0 + k; const float Ar = Apow[((dir * 64 + p) * 34 + e) * 2], Ai = Apow[((dir * 64 + p) * 34 + e) * 2 + 1];
                const float Cr = Cc[((dir * 16 + h) * 64 + p) * 2], Ci = Cc[((dir * 16 + h) * 64 + p) * 2 + 1];
                v[2 * k] = Cr * Ar - Ci * Ai; v[2 * k + 1] = -(Cr * Ai + Ci * Ar); }
        }
        v4u o; o.x = pk2(v[0], v[1]); o.y = pk2(v[2], v[3]); o.z = pk2(v[4], v[5]); o.w = pk2(v[6], v[7]);
        *(v4u*)(MQt + ((size_t)(g * 512 + i * 16 + h) * KA + ch * 8)) = o;
    }
    for (int idx = tid; idx < 64 * 64; idx += NTHR) {
        const int scl = idx >> 6, ch = idx & 63, sc = 64 * q + scl, dir = sc >> 7, p = (sc & 127) >> 1, ri = sc & 1, j = ch >> 1, h0 = (ch & 1) * 8, e = dir ? j : 31 - j;
        const float Ar = Apow[((dir * 64 + p) * 34 + e) * 2], Ai = Apow[((dir * 64 + p) * 34 + e) * 2 + 1];
        float v[8];
#pragma unroll
        for (int k = 0; k < 8; ++k) { const float Br = Bb[((dir * 64 + p) * 16 + h0 + k) * 2], Bi = Bb[((dir * 64 + p) * 16 + h0 + k) * 2 + 1]; v[k] = ri ? (Ar * Bi + Ai * Br) : (Ar * Br - Ai * Bi); }
        v4u o; o.x = pk2(v[0], v[1]); o.y = pk2(v[2], v[3]); o.z = pk2(v[4], v[5]); o.w = pk2(v[6], v[7]);
        *(v4u*)(Pt + ((size_t)(g * 256 + sc) * 512 + ch * 8)) = o;
    }
    if (q == 0 && tid < 128) { const int dir = tid >> 6, p = tid & 63; ATt[((g * 2 + dir) * 64 + p) * 2] = Apow[((dir * 64 + p) * 34 + 32) * 2]; ATt[((g * 2 + dir) * 64 + p) * 2 + 1] = Apow[((dir * 64 + p) * 34 + 32) * 2 + 1]; }
    __syncthreads();
}

__global__ void __launch_bounds__(NTHR, 2) s5conv_fwd(Args a) {
    extern __shared__ __attribute__((aligned(16))) unsigned char lds_raw[];
    LAS unsigned char* lds = (LAS unsigned char*)lds_raw;
    cg::grid_group grid = cg::this_grid();
    const int tid = threadIdx.x, lane = tid & 63, wave = __builtin_amdgcn_readfirstlane(tid >> 6);
    const int G = gridDim.x, bx = blockIdx.x;
    const int gw = bx * NWAVES + wave, NGW = G * NWAVES;
    unsigned char* ws = a.ws;
    bf16 *WinT = (bf16*)(ws + WS_WIN), *WgluT = (bf16*)(ws + WS_WGLU), *WaT = (bf16*)(ws + WS_WA), *WbT = (bf16*)(ws + WS_WB), *WoutT = (bf16*)(ws + WS_WOUT);
    bf16 *Pt = (bf16*)(ws + WS_PT), *MQt = (bf16*)(ws + WS_MQT), *XN = (bf16*)(ws + WS_XN), *YA = (bf16*)(ws + WS_XN), *ACAT = (bf16*)(ws + WS_ACAT), *E = (bf16*)(ws + WS_E);
    bf16 *SZA = (bf16*)(ws + WS_ACAT), *SGB = (bf16*)(ws + WS_ACAT + 64 * MiB), *CV = (bf16*)(ws + WS_CV), *GY = (bf16*)(ws + WS_CV), *MG = (bf16*)(ws + WS_CV), *BZ = (bf16*)(ws + WS_BZ), *SGA = (bf16*)(ws + WS_BZ), *YB = (bf16*)(ws + WS_YB);
    float* SSQ = (float*)(ws + WS_SSQ);
    const int lo = a.ph_lo, hi = a.ph_hi;
    volatile LAS unsigned* MISC = (volatile LAS unsigned*)(lds + 140000);
    if (tid < 2) MISC[tid] = 0u;
    __syncthreads();
    XcdBarrier xbar = xcd_barrier_post((unsigned*)(ws + WS_BAR), MISC);
#define IN(k) (lo <= (k) && (k) < hi)
#define SEAM(k) do { if (IN(k) && IN((k) + 1)) { if ((k) == 0) grid.sync(); else xcd_barrier(xbar); } } while (0)

    if (IN(0)) {
        for (int u = bx; u < NG * 4; u += G) p0_ssm_setup(a, lds, u >> 2, u & 3, tid);
        LAS float* scr = (LAS float*)(lds + wave * 16384);
        for (int it = gw; it < 4096 + 4 * 512; it += NGW) {
            if (it < 4096) { const int kb = it >> 8, nb = it & 255; p0_transpose_item(a.in[2], NIN, win_src(nb * 32), WinT, D, nb * 32, kb * 64, scr, lane); }
            else { const int r = it - 4096, w = r >> 9, kb = (r & 511) >> 5, nb = r & 31;
                const float* W = w == 0 ? a.in[11] : w == 1 ? a.in[14] : w == 2 ? a.in[15] : a.in[16]; bf16* WT = w == 0 ? WgluT : w == 1 ? WaT : w == 2 ? WbT : WoutT;
                p0_transpose_item(W, D, nb * 32, WT, D, nb * 32, kb * 64, scr, lane); }
        }
        const float* ng = a.in[1];
        f32x4 gv[4];
#pragma unroll
        for (int j = 0; j < 4; ++j) gv[j] = *((const f32x4*)ng + lane + 64 * j);
        for (int m0 = gw * 4; m0 < M; m0 += NGW * 4) {
            f32x4 v[4][4]; float sq[4];
#pragma unroll
            for (int r = 0; r < 4; ++r) { const f32x4* xr = (const f32x4*)(a.in[0] + (size_t)(m0 + r) * D) + lane;
#pragma unroll
                for (int j = 0; j < 4; ++j) v[r][j] = xr[64 * j]; }
#pragma unroll
            for (int r = 0; r < 4; ++r) { float t = 0.f;
#pragma unroll
                for (int j = 0; j < 4; ++j) t += (v[r][j].x * v[r][j].x + v[r][j].y * v[r][j].y) + (v[r][j].z * v[r][j].z + v[r][j].w * v[r][j].w);
                sq[r] = t; }
#pragma unroll
            for (int o = 1; o < 64; o <<= 1) {
#pragma unroll
                for (int r = 0; r < 4; ++r) sq[r] += __shfl_xor(sq[r], o); }
#pragma unroll
            for (int r = 0; r < 4; ++r) { const float rs = 1.0f / sqrtf(sq[r] * (1.f / D) + EPS);
                unsigned long long* o8 = (unsigned long long*)(XN + (size_t)(m0 + r) * D) + lane;
#pragma unroll
                for (int j = 0; j < 4; ++j) { const f32x4 t = v[r][j] * rs * gv[j]; o8[64 * j] = (unsigned long long)pk2(t.x, t.y) | ((unsigned long long)pk2(t.z, t.w) << 32); } }
        }
    }
    SEAM(0);
    if (IN(1)) {
        pg8::Gemm g{XN, WinT, D, D, D}; pg8::StaticOrder S; S.init(M, 20 * 256, G, bx);
        pg8::EpiP1 Ep{ACAT, SZA, CV, BZ, SGA, SGB, 0};
        RUN_GEMM(1, pg8::EpiP1, pg8::StaticOrder, g, S, Ep);
    }
    SEAM(1);
    if (IN(2)) {
        pg8::Gemm g{ACAT, Pt, KA, 512, 512}; pg8::GroupOrder S{4, 1, NG * 4, G, bx};
        pg8::EpiE Ep{E};
        RUN_GEMM(2, pg8::EpiE, pg8::GroupOrder, g, S, Ep);
    }
    SEAM(2);
    if (IN(3)) {
        const float* ATt = (const float*)(ws + WS_AT);
        if (wave < 4) for (int w = bx * 4 + wave; w < NG * 8 * 2; w += G * 4) {
            const int g = w >> 4, b = (w >> 1) & 7, dir = w & 1, p = lane;
            const float ar = ATt[((g * 2 + dir) * 64 + p) * 2], ai = ATt[((g * 2 + dir) * 64 + p) * 2 + 1];
            const size_t n0 = (size_t)g * 1024 + b * 128;
            const unsigned* __restrict__ Ep = (const unsigned*)(E + n0 * 256 + dir * 128) + p;
            unsigned* __restrict__ Sp = (unsigned*)(ACAT + n0 * KA + 512 + dir * 128) + p;
            float sr = 0.f, si = 0.f;
            Sp[dir ? (size_t)127 * 384 : 0] = 0u;
            for (int k0 = 0; k0 < 128; k0 += 16) {
                unsigned e[16];
#pragma unroll
                for (int i = 0; i < 16; ++i) { const int k = k0 + i, c = dir ? 127 - k : k; e[i] = (k < 127) ? Ep[(size_t)c * 128] : 0u; }
#pragma unroll
                for (int i = 0; i < 16; ++i) { const int k = k0 + i, c = dir ? 127 - k : k;
                    if (k < 127) { const float er = __uint_as_float(e[i] << 16), ei = __uint_as_float(e[i] & 0xffff0000u);
                        const float nr = ar * sr - ai * si + er, ni = ar * si + ai * sr + ei; sr = nr; si = ni; Sp[(size_t)(dir ? c - 1 : c + 1) * 384] = pk2(sr, si); } }
            }
        }
        {
            const int gt = bx * NTHR + tid, ch = gt & 127; const float *cw = a.in[12], *cb = a.in[13];
            f32x4 w0[2], w1[2], w2[2], bb[2];
#pragma unroll
            for (int k = 0; k < 2; ++k) { w0[k] = *(const f32x4*)(cw + ch * 8 + 4 * k); w1[k] = *(const f32x4*)(cw + D + ch * 8 + 4 * k); w2[k] = *(const f32x4*)(cw + 2 * D + ch * 8 + 4 * k); bb[k] = *(const f32x4*)(cb + ch * 8 + 4 * k); }
            for (int it0 = gt; it0 < M * 128; it0 += 4 * G * NTHR) {
                v4u q0[4], q1[4], q2[4], qz[4];
                const v4u zero = (v4u){0u, 0u, 0u, 0u};
#pragma unroll
                for (int u = 0; u < 4; ++u) { const int it = it0 + u * G * NTHR, r = it >> 7, t = r & (SEQ - 1); const size_t off = (size_t)r * D + ch * 8;
                    q0[u] = t > 0 ? *(const v4u*)(CV + off - D) : zero; q1[u] = *(const v4u*)(CV + off); q2[u] = t < SEQ - 1 ? *(const v4u*)(CV + off + D) : zero; qz[u] = *(const v4u*)(BZ + off); }
#pragma unroll
                for (int u = 0; u < 4; ++u) { const int it = it0 + u * G * NTHR, r = it >> 7; const size_t off = (size_t)r * D + ch * 8;
                    f32x4 c0a, c0b, c1a, c1b, c2a, c2b, za, zb;
                    pg8::unpack8(q0[u], c0a, c0b); pg8::unpack8(q1[u], c1a, c1b); pg8::unpack8(q2[u], c2a, c2b); pg8::unpack8(qz[u], za, zb);
                    const f32x4 ya = za * (bb[0] + w0[0] * c0a + w1[0] * c1a + w2[0] * c2a), yb = zb * (bb[1] + w0[1] * c0b + w1[1] * c1b + w2[1] * c2b);
                    *(v4u*)(YB + off) = pg8::pack8(ya, yb); }
            }
        }
    }
    SEAM(3);
    if (IN(4)) {
        pg8::Gemm g{ACAT, MQt, KA, KA, KA}; pg8::GroupOrder S{8, 2, NG * 8, G, bx};
        pg8::EpiY Ep{GY};
        RUN_GEMM(4, pg8::EpiY, pg8::GroupOrder, g, S, Ep);
    }
    SEAM(4);
    if (IN(5)) {
        pg8::Gemm g{XN, WinT + (size_t)20 * 256 * D, D, D, D}; pg8::StaticOrder S; S.init(M, 12 * 256, G, bx);
        pg8::EpiP1 Ep{ACAT, SZA, CV, BZ, SGA, SGB, 20};
        RUN_GEMM(5, pg8::EpiP1, pg8::StaticOrder, g, S, Ep);
    }
    SEAM(5);
    if (IN(6)) {
        pg8::Gemm g{GY, WgluT, D, D, D}; pg8::StaticOrder S; S.init(M, D, G, bx);
        pg8::EpiGLU Ep{GY, SZA, YA};
        RUN_GEMM(6, pg8::EpiGLU, pg8::StaticOrder, g, S, Ep);
    }
    SEAM(6);
    if (IN(7)) {
        pg8::Gemm g{YA, WaT, D, D, D}; pg8::PairOrder S; S.so.init(M, D, G, bx); S.A1 = YB; S.B1 = WbT;
        pg8::EpiPair Ep{SGA  , SGB, MG};
        RUN_GEMM(7, pg8::EpiPair, pg8::PairOrder, g, S, Ep);
    }
    SEAM(7);
    if (IN(8)) {
        pg8::Gemm g{MG, WoutT, D, D, D}; pg8::StaticOrder S; S.init(M, D, G, bx);
        pg8::EpiOut Ep{a.in[0], a.out, SSQ};
        RUN_GEMM(8, pg8::EpiOut, pg8::StaticOrder, g, S, Ep);
    }
    SEAM(8);
    if (IN(9)) {
        const float* fg = a.in[17];
        f32x4 gv[4];
#pragma unroll
        for (int j = 0; j < 4; ++j) gv[j] = *((const f32x4*)fg + lane + 64 * j);
        for (int m0 = gw * 4; m0 < M; m0 += NGW * 4) {
            f32x4 v[4][4]; float sq[4];
#pragma unroll
            for (int r = 0; r < 4; ++r) { sq[r] = SSQ[(size_t)(m0 + r) * 16 + (lane & 15)]; const f32x4* hr = (const f32x4*)(a.out + (size_t)(m0 + r) * D) + lane;
#pragma unroll
                for (int j = 0; j < 4; ++j) v[r][j] = hr[64 * j]; }
#pragma unroll
            for (int o = 1; o < 16; o <<= 1) {
#pragma unroll
                for (int r = 0; r < 4; ++r) sq[r] += __shfl_xor(sq[r], o); }
#pragma unroll
            for (int r = 0; r < 4; ++r) { const float rs = 1.0f / sqrtf(sq[r] * (1.f / D) + EPS); f32x4* hr = (f32x4*)(a.out + (size_t)(m0 + r) * D) + lane;
#pragma unroll
                for (int j = 0; j < 4; ++j) hr[64 * j] = v[r][j] * rs * gv[j]; }
        }
    }
#undef IN
#undef SEAM
}

#ifndef MK_PER_PHASE
#define MK_PER_PHASE 0
#endif
constexpr int N_PHASES = 10;
extern "C" void kernel_launch(void* const* d_in, const int* in_sizes, int n_in, void* d_out, int out_size, void* d_ws, size_t ws_size, hipStream_t stream) {
    static int grid = 0;
    if (grid == 0) {
        if (n_in != 18 || in_sizes[0] != M * D || out_size != M * D || ws_size < WS_END) { fprintf(stderr, "kernel_launch: unexpected shapes (n_in %d, in0 %d, out %d, ws %zu)\n", n_in, n_in > 0 ? in_sizes[0] : -1, out_size, ws_size); grid = -1; return; }
        int dev = 0, cus = 0, per_cu = 0;
        if (hipGetDevice(&dev) != hipSuccess || hipDeviceGetAttribute(&cus, hipDeviceAttributeMultiprocessorCount, dev) != hipSuccess) { grid = -1; return; }
        if (hipFuncSetAttribute((const void*)s5conv_fwd, hipFuncAttributeMaxDynamicSharedMemorySize, LDS_BYTES) != hipSuccess) { fprintf(stderr, "kernel_launch: hipFuncSetAttribute failed\n"); grid = -1; return; }
        if (hipOccupancyMaxActiveBlocksPerMultiprocessor(&per_cu, (const void*)s5conv_fwd, NTHR, LDS_BYTES) != hipSuccess || per_cu < 1) { fprintf(stderr, "kernel_launch: occupancy query says %d\n", per_cu); per_cu = 1; }
        (void)hipGetLastError();
        grid = cus * 1;
    }
    if (grid < 0) return;
    Args a{};
    for (int i = 0; i < 18; ++i) a.in[i] = (const float*)d_in[i];
    a.out = (float*)d_out; a.ws = (unsigned char*)d_ws;
#if MK_PER_PHASE
    for (int ph = 0; ph < N_PHASES; ++ph) { a.ph_lo = ph; a.ph_hi = ph + 1; hipLaunchKernelGGL(s5conv_fwd, dim3(grid), dim3(NTHR), LDS_BYTES, stream, a); }
#else
    a.ph_lo = 0; a.ph_hi = N_PHASES;
    if (hipMemsetAsync((char*)d_ws + WS_BAR, 0, XCD_BAR_WORDS * 4, stream) != hipSuccess) { fprintf(stderr, "kernel_launch: memset of the barrier words failed\n"); return; }
    void* args[] = {&a};
    hipError_t e = hipLaunchCooperativeKernel((const void*)s5conv_fwd, dim3(grid), dim3(NTHR), args, LDS_BYTES, stream);
    if (e != hipSuccess) fprintf(stderr, "kernel_launch: cooperative launch failed: %s (grid %d)\n", hipGetErrorString(e), grid);
#endif
}
```
